# Optimizing an MI355X kernel written in HIP

```python
import math
import jax
import jax.numpy as jnp
from jax import lax
import numpy as np

D_MODEL = 1024
BATCH = 4
SEQ = 8192
DEPTH = 2

CTX_LEN = 256
GRID_W = 64
EPS = 1e-6
HEAD_DIM = 64
ROPE_THETA = 10000.0
ATT_HEADS = 8
ATT_KV_HEADS = 2
ATT_GROUP = ATT_HEADS // ATT_KV_HEADS
WINDOW = 128
ATT_BLOCK = 128
ATT_Q_W = ATT_HEADS * HEAD_DIM
ATT_KV_W = ATT_KV_HEADS * HEAD_DIM
SSM_HEADS = 8
SSM_HEAD_DIM = 64
SSM_INNER = SSM_HEADS * SSM_HEAD_DIM
SSM_GROUPS = 2
SSM_STATE = 64
SSM_CONV = 3
SSM_CHUNK = 128
SSM_BC_W = SSM_GROUPS * SSM_STATE
SSM_XBC_W = SSM_INNER + 2 * SSM_BC_W
DT_MIN = 0.001
DT_MAX = 0.1
FNET_GROUPS = 8
FNET_GROUP_DIM = 64
FNET_WIDTH = FNET_GROUPS * FNET_GROUP_DIM
SCONV_WIDTH = 512
SCONV_K = 3
N_BRANCHES = 4
BRANCH_W = 512
IN_SIZES = (ATT_Q_W, ATT_KV_W, ATT_KV_W, SSM_INNER, SSM_XBC_W, 2 * SSM_HEADS, FNET_WIDTH, 3 * SCONV_WIDTH)
IN_PROJ_W = sum(IN_SIZES)
N_EXPERTS = 32
N_EXPERT_GROUPS = 8
EXPERTS_PER_GROUP = N_EXPERTS // N_EXPERT_GROUPS
TOP_K = 2
D_EXPERT = 512
EXPERT_BLOCK = 128

kernel_name = "hybrid_gated_mixers_moe_dit"


def _rmsnorm(x, g):
    xf = x.astype(jnp.float32)
    y = xf * lax.rsqrt(jnp.mean(xf * xf, axis=-1, keepdims=True) + EPS)
    return y.astype(x.dtype) * g


def _modulate(h, shift, scale):
    return h * (1 + scale) + shift


def _dwconv(x, w, b=None):
    k, ch = w.shape
    y = lax.conv_general_dilated(x, w[:, None, :], window_strides=(1,), padding=[((k - 1) // 2, k // 2)],
                                 dimension_numbers=("NWC", "WIO", "NWC"), feature_group_count=ch)
    return y if b is None else y + b


def _split_in(p):
    cuts = np.cumsum(IN_SIZES)[:-1].tolist()
    return jnp.split(p, cuts, axis=-1)


def _axial_rope(n):
    rows = n // GRID_W
    row = jnp.repeat(jnp.arange(rows, dtype=jnp.float32), GRID_W)
    col = jnp.tile(jnp.arange(GRID_W, dtype=jnp.float32), rows)
    pairs = HEAD_DIM // 4
    inv_freq = ROPE_THETA ** (-jnp.arange(pairs, dtype=jnp.float32) / pairs)
    ang = jnp.concatenate([row[:, None] * inv_freq, col[:, None] * inv_freq], axis=-1)
    return jnp.cos(ang), jnp.sin(ang)


def _rope(x, cos, sin):
    x1, x2 = jnp.split(x, 2, axis=-1)
    c = cos[:, None, :].astype(x.dtype)
    s = sin[:, None, :].astype(x.dtype)
    return jnp.concatenate([x1 * c - x2 * s, x2 * c + x1 * s], axis=-1)


def _window_attention(q, k, v, k_ctx, v_ctx, sink):
    b, s, kvh, g, dh = q.shape
    nb = s // ATT_BLOCK
    scale = dh ** -0.5
    qb = q.reshape(b, nb, ATT_BLOCK, kvh, g, dh)

    def band(t):
        tb = t.reshape(b, nb, ATT_BLOCK, kvh, dh)
        z = jnp.zeros_like(tb[:, :1])
        tp = jnp.concatenate([z, tb, z], axis=1)
        return jnp.concatenate([tp[:, :-2], tp[:, 1:-1], tp[:, 2:]], axis=2)

    kw, vw = band(k), band(v)
    sink_f = sink.astype(jnp.float32).reshape(kvh, g, 1, 1)
    qi = jnp.arange(ATT_BLOCK)
    kj = jnp.arange(3 * ATT_BLOCK)

    def block(args):
        qn, kn, vn, n = args
        s_loc = jnp.einsum("bqkgd,bjkd->bkgqj", qn, kn).astype(jnp.float32) * scale
        kabs = (n - 1) * ATT_BLOCK + kj
        qabs = n * ATT_BLOCK + qi
        valid = (jnp.abs(kabs[None, :] - qabs[:, None]) <= WINDOW) & (kabs >= 0)[None, :] & (kabs < s)[None, :]
        s_loc = jnp.where(valid, s_loc, -jnp.inf)
        s_ctx = jnp.einsum("bqkgd,bckd->bkgqc", qn, k_ctx).astype(jnp.float32) * scale
        sink_col = jnp.broadcast_to(sink_f, s_loc.shape[:-1] + (1,))
        probs = jax.nn.softmax(jnp.concatenate([s_loc, s_ctx, sink_col], axis=-1), axis=-1).astype(vn.dtype)
        p_loc = probs[..., :3 * ATT_BLOCK]
        p_ctx = probs[..., 3 * ATT_BLOCK:-1]
        return (jnp.einsum("bkgqj,bjkd->bqkgd", p_loc, vn)
                + jnp.einsum("bkgqc,bckd->bqkgd", p_ctx, v_ctx))

    outs = lax.map(block, (jnp.moveaxis(qb, 1, 0), jnp.moveaxis(kw, 1, 0), jnp.moveaxis(vw, 1, 0),
                           jnp.arange(nb)))
    return jnp.moveaxis(outs, 0, 1).reshape(b, s, kvh * g * dh)


def _context_attention(q, k, v, sink):
    b, lc, kvh, g, dh = q.shape
    sc = jnp.einsum("bqkgd,bckd->bkgqc", q, k).astype(jnp.float32) * dh ** -0.5
    sink_col = jnp.broadcast_to(sink.astype(jnp.float32).reshape(kvh, g, 1, 1), sc.shape[:-1] + (1,))
    probs = jax.nn.softmax(jnp.concatenate([sc, sink_col], axis=-1), axis=-1)[..., :-1].astype(v.dtype)
    return jnp.einsum("bkgqc,bckd->bqkgd", probs, v).reshape(b, lc, kvh * g * dh)


def _ssd(x, dt, a, bm, cm, init, with_output):
    b, l, h, p = x.shape
    n = bm.shape[-1]
    nc = l // SSM_CHUNK
    a_cs = jnp.cumsum((dt * a).reshape(b, nc, SSM_CHUNK, h), axis=2)
    xd = (x * dt[..., None]).reshape(b, nc, SSM_CHUNK, h, p)
    bc = bm.reshape(b, nc, SSM_CHUNK, h, n)
    decay_to_end = jnp.exp(a_cs[:, :, -1:] - a_cs)
    chunk_states = jnp.einsum("bcqhn,bcqhp->bchpn", bc * decay_to_end[..., None], xd)
    chunk_decay = jnp.exp(a_cs[:, :, -1])

    def step(state, inp):
        st, dec = inp
        return state * dec[:, :, None, None] + st, state

    final, prev = lax.scan(step, init, (jnp.moveaxis(chunk_states, 1, 0), jnp.moveaxis(chunk_decay, 1, 0)))
    if not with_output:
        return None, final
    prev = jnp.moveaxis(prev, 0, 1)
    cc = cm.reshape(b, nc, SSM_CHUNK, h, n)
    seg = a_cs[:, :, :, None, :] - a_cs[:, :, None, :, :]
    tri = jnp.tril(jnp.ones((SSM_CHUNK, SSM_CHUNK), dtype=bool))[None, None, :, :, None]
    lmat = jnp.exp(jnp.where(tri, seg, -jnp.inf))
    scores = jnp.einsum("bcihn,bcjhn->bcijh", cc, bc) * lmat
    y_diag = jnp.einsum("bcijh,bcjhp->bcihp", scores, xd)
    y_off = jnp.einsum("bcihn,bchpn->bcihp", cc, prev) * jnp.exp(a_cs)[..., None]
    return (y_diag + y_off).reshape(b, l, h, p), final


def _ssm_prep(xbc, dt_raw, conv_w, conv_b, dt_bias):
    b, l, _ = xbc.shape
    xbc = jax.nn.silu(_dwconv(xbc, conv_w, conv_b)).astype(jnp.float32)
    xs, bg, cg = jnp.split(xbc, [SSM_INNER, SSM_INNER + SSM_BC_W], axis=-1)
    rep = SSM_HEADS // SSM_GROUPS
    xs = xs.reshape(b, l, SSM_HEADS, SSM_HEAD_DIM)
    bm = jnp.repeat(bg.reshape(b, l, SSM_GROUPS, SSM_STATE), rep, axis=2)
    cm = jnp.repeat(cg.reshape(b, l, SSM_GROUPS, SSM_STATE), rep, axis=2)
    dt = jax.nn.softplus(dt_raw.astype(jnp.float32).reshape(b, l, 2, SSM_HEADS) + dt_bias.astype(jnp.float32))
    return xs, bm, cm, dt


def _ssm_bidir(xs, bm, cm, dt, a_log, init_f, init_b, with_output):
    a = -jnp.exp(a_log.astype(jnp.float32))
    flip = lambda t: jnp.flip(t, axis=1)
    y_f, fin_f = _ssd(xs, dt[:, :, 0], a[0], bm, cm, init_f, with_output)
    y_b, fin_b = _ssd(flip(xs), flip(dt[:, :, 1]), a[1], flip(bm), flip(cm), init_b, with_output)
    if not with_output:
        return None, fin_f, fin_b
    return y_f + flip(y_b), fin_f, fin_b


def _ssm_out(y, xs, z, d_skip, norm_w):
    b, l = z.shape[:2]
    y = (y + d_skip.astype(jnp.float32)[:, None] * xs).reshape(b, l, SSM_INNER)
    y = y * jax.nn.silu(z.astype(jnp.float32))
    return _rmsnorm(y, norm_w).astype(z.dtype)


def _fourier(u):
    b, l, _ = u.shape
    uf = u.astype(jnp.float32).reshape(b, l, FNET_GROUPS, FNET_GROUP_DIM)
    y = jnp.fft.fft2(uf, axes=(1, 3), norm="ortho").real
    return y.reshape(b, l, FNET_WIDTH).astype(u.dtype)


def _short_conv(p, w):
    bg, cg, xs = jnp.split(p, 3, axis=-1)
    return bg * _dwconv(cg * xs, w)


def _merge(h, branches, w_gate, b_gate, w_branch, w_o):
    b, l, d = h.shape
    gates = jax.nn.sigmoid(h @ w_gate + b_gate).reshape(b, l, N_BRANCHES, d)
    proj = jnp.einsum("blnw,nwd->blnd", branches, w_branch)
    return jnp.sum(gates * proj, axis=2) @ w_o


def _token_mixer(h, hc, w_in, sink, conv_w, conv_b, dt_bias, a_log, d_skip, ssm_norm_w, sconv_w,
                 w_gate, b_gate, w_branch, w_o, cos, sin, need_ctx):
    b, s, _ = h.shape
    lc = hc.shape[1]
    q, k, v, z, xbc, dtr, fu, su = _split_in(h @ w_in)
    qc, kc, vc, zc, xbcc, dtrc, fuc, suc = _split_in(hc @ w_in)
    q = _rope(q.reshape(b, s, ATT_HEADS, HEAD_DIM), cos, sin).reshape(b, s, ATT_KV_HEADS, ATT_GROUP, HEAD_DIM)
    k = _rope(k.reshape(b, s, ATT_KV_HEADS, HEAD_DIM), cos, sin)
    v = v.reshape(b, s, ATT_KV_HEADS, HEAD_DIM)
    kc = kc.reshape(b, lc, ATT_KV_HEADS, HEAD_DIM)
    vc = vc.reshape(b, lc, ATT_KV_HEADS, HEAD_DIM)
    att = _window_attention(q, k, v, kc, vc, sink)
    xs_c, bm_c, cm_c, dt_c = _ssm_prep(xbcc, dtrc, conv_w, conv_b, dt_bias)
    zero = jnp.zeros((b, SSM_HEADS, SSM_HEAD_DIM, SSM_STATE), jnp.float32)
    y_c, fin_f, fin_b = _ssm_bidir(xs_c, bm_c, cm_c, dt_c, a_log, zero, zero, need_ctx)
    xs, bm, cm, dt = _ssm_prep(xbc, dtr, conv_w, conv_b, dt_bias)
    y, _, _ = _ssm_bidir(xs, bm, cm, dt, a_log, fin_f, fin_b, True)
    ssm = _ssm_out(y, xs, z, d_skip, ssm_norm_w)
    branches = jnp.stack([att, ssm, _fourier(fu), _short_conv(su, sconv_w)], axis=2)
    out = _merge(h, branches, w_gate, b_gate, w_branch, w_o)
    if not need_ctx:
        return out, None
    att_c = _context_attention(qc.reshape(b, lc, ATT_KV_HEADS, ATT_GROUP, HEAD_DIM), kc, vc, sink)
    ssm_c = _ssm_out(y_c, xs_c, zc, d_skip, ssm_norm_w)
    branches_c = jnp.stack([att_c, ssm_c, _fourier(fuc), _short_conv(suc, sconv_w)], axis=2)
    return out, _merge(hc, branches_c, w_gate, b_gate, w_branch, w_o)


def _route(t, w_router, router_bias):
    n = t.shape[0]
    scores = jax.nn.sigmoid((t @ w_router).astype(jnp.float32))
    sel = (scores + router_bias.astype(jnp.float32)).reshape(n, N_EXPERT_GROUPS, EXPERTS_PER_GROUP)
    group_score = jnp.sum(lax.top_k(sel, 2)[0], axis=-1)
    best = jnp.argmax(group_score, axis=-1)
    in_group = jnp.take_along_axis(sel, best[:, None, None], axis=1)[:, 0]
    _, local = lax.top_k(in_group, TOP_K)
    idx = best[:, None] * EXPERTS_PER_GROUP + local
    w = jnp.take_along_axis(scores, idx, axis=1)
    return idx, w / jnp.sum(w, axis=-1, keepdims=True)


def _expert_ffn(t, idx, wts, w1, w3, w2):
    n, d = t.shape
    flat_e = idx.reshape(-1)
    a = flat_e.shape[0]
    order = jnp.argsort(flat_e)
    e_sorted = flat_e[order]
    tok = order // TOP_K
    counts = jnp.bincount(flat_e, length=N_EXPERTS)
    padded = (counts + EXPERT_BLOCK - 1) // EXPERT_BLOCK * EXPERT_BLOCK
    pad_end = jnp.cumsum(padded)
    grp_start = jnp.cumsum(counts) - counts
    dest = (pad_end - padded)[e_sorted] + jnp.arange(a) - grp_start[e_sorted]
    n_blocks = -(-a // EXPERT_BLOCK) + N_EXPERTS
    buf = jnp.zeros((n_blocks * EXPERT_BLOCK, d), t.dtype).at[dest].set(t[tok])
    block_expert = jnp.minimum(jnp.searchsorted(pad_end, jnp.arange(n_blocks) * EXPERT_BLOCK, side="right"),
                               N_EXPERTS - 1)

    def expert_block(args):
        xb, e = args
        return (jax.nn.silu(xb @ w1[e]) * (xb @ w3[e])) @ w2[e]

    yb = lax.map(expert_block, (buf.reshape(n_blocks, EXPERT_BLOCK, d), block_expert))
    y_rows = yb.reshape(-1, d)[dest] * wts.reshape(-1)[order][:, None].astype(t.dtype)
    return jnp.zeros_like(t).at[tok].add(y_rows)


def _moe(t, w_router, router_bias, w1, w3, w2):
    idx, wts = _route(t, w_router, router_bias)
    return _expert_ffn(t, idx, wts, w1, w3, w2)


def setup_inputs(seed: int = 0) -> dict:
    key = jax.random.key(seed)
    ks = jax.random.split(key, 28)
    f32 = jnp.float32
    nrm = lambda k, shape, scale: jax.random.normal(k, shape, f32) * scale
    L, D = DEPTH, D_MODEL
    dt0 = jnp.exp(jax.random.uniform(ks[12], (L, 2, SSM_HEADS), f32, math.log(DT_MIN), math.log(DT_MAX)))
    return {
        "x": nrm(ks[0], (BATCH, SEQ, D), 1.0),
        "c": nrm(ks[1], (BATCH, D), 1.0),
        "ctx": nrm(ks[2], (BATCH, CTX_LEN, D), 1.0),
        "c_ctx": nrm(ks[3], (D,), 1.0),
        "norm1_w": 1.0 + nrm(ks[4], (L, D), 0.02),
        "norm2_w": 1.0 + nrm(ks[5], (L, D), 0.02),
        "w_ada": nrm(ks[6], (L, D, 6 * D), 0.5 * D ** -0.5),
        "b_ada": nrm(ks[7], (L, 6 * D), 0.02),
        "w_in": nrm(ks[8], (L, D, IN_PROJ_W), D ** -0.5),
        "attn_sink": nrm(ks[9], (L, ATT_HEADS), 0.5),
        "ssm_conv_w": nrm(ks[10], (L, SSM_CONV, SSM_XBC_W), SSM_CONV ** -0.5),
        "ssm_conv_b": nrm(ks[11], (L, SSM_XBC_W), 0.02),
        "ssm_dt_bias": dt0 + jnp.log(-jnp.expm1(-dt0)),
        "ssm_a_log": jnp.log(jax.random.uniform(ks[13], (L, 2, SSM_HEADS), f32, 1.0, 16.0)),
        "ssm_d": 1.0 + nrm(ks[14], (L, SSM_HEADS), 0.1),
        "ssm_norm_w": 1.0 + nrm(ks[15], (L, SSM_INNER), 0.02),
        "sconv_w": nrm(ks[16], (L, SCONV_K, SCONV_WIDTH), SCONV_K ** -0.5),
        "w_gate": nrm(ks[17], (L, D, N_BRANCHES * D), D ** -0.5),
        "b_gate": nrm(ks[18], (L, N_BRANCHES * D), 0.02),
        "w_branch": nrm(ks[19], (L, N_BRANCHES, BRANCH_W, D), BRANCH_W ** -0.5),
        "w_o": nrm(ks[20], (L, D, D), D ** -0.5),
        "w_router": nrm(ks[21], (D, N_EXPERTS), D ** -0.5),
        "router_bias": nrm(ks[22], (N_EXPERTS,), 0.01),
        "moe_w1": nrm(ks[23], (L, N_EXPERTS, D, D_EXPERT), D ** -0.5),
        "moe_w3": nrm(ks[24], (L, N_EXPERTS, D, D_EXPERT), D ** -0.5),
        "moe_w2": nrm(ks[25], (L, N_EXPERTS, D_EXPERT, D), D_EXPERT ** -0.5),
        "final_norm_w": 1.0 + nrm(ks[26], (D,), 0.02),
    }


def reference(x, c, ctx, c_ctx, norm1_w, norm2_w, w_ada, b_ada, w_in, attn_sink, ssm_conv_w, ssm_conv_b,
              ssm_dt_bias, ssm_a_log, ssm_d, ssm_norm_w, sconv_w, w_gate, b_gate, w_branch, w_o,
              w_router, router_bias, moe_w1, moe_w3, moe_w2, final_norm_w):
    b, s, d = x.shape
    lc = ctx.shape[1]
    cos, sin = _axial_rope(s)
    sc = jax.nn.silu(c)
    scc = jax.nn.silu(c_ctx)
    xc = ctx
    for layer in range(DEPTH):
        need_ctx = layer + 1 < DEPTH
        mod = jnp.split(sc @ w_ada[layer] + b_ada[layer], 6, axis=-1)
        mod_c = jnp.split(scc @ w_ada[layer] + b_ada[layer], 6, axis=-1)
        h = _modulate(_rmsnorm(x, norm1_w[layer]), mod[0][:, None], mod[1][:, None])
        hc = _modulate(_rmsnorm(xc, norm1_w[layer]), mod_c[0], mod_c[1])
        y, yc = _token_mixer(h, hc, w_in[layer], attn_sink[layer], ssm_conv_w[layer], ssm_conv_b[layer],
                             ssm_dt_bias[layer], ssm_a_log[layer], ssm_d[layer], ssm_norm_w[layer],
                             sconv_w[layer], w_gate[layer], b_gate[layer], w_branch[layer], w_o[layer],
                             cos, sin, need_ctx)
        x = x + mod[2][:, None] * y
        h2 = _modulate(_rmsnorm(x, norm2_w[layer]), mod[3][:, None], mod[4][:, None])
        if need_ctx:
            xc = xc + mod_c[2] * yc
            h2c = _modulate(_rmsnorm(xc, norm2_w[layer]), mod_c[3], mod_c[4])
            tokens = jnp.concatenate([h2.reshape(-1, d), h2c.reshape(-1, d)], axis=0)
            f = _moe(tokens, w_router, router_bias, moe_w1[layer], moe_w3[layer], moe_w2[layer])
            x = x + mod[5][:, None] * f[:b * s].reshape(b, s, d)
            xc = xc + mod_c[5] * f[b * s:].reshape(b, lc, d)
        else:
            f = _moe(h2.reshape(-1, d), w_router, router_bias, moe_w1[layer], moe_w3[layer], moe_w2[layer])
            x = x + mod[5][:, None] * f.reshape(b, s, d)
    return _rmsnorm(x, final_norm_w)
```

```cpp
#include <hip/hip_runtime.h>
#include <hip/hip_cooperative_groups.h>
#include <cstdio>
#include <cstdint>
namespace cg = cooperative_groups;

#define LAS __attribute__((address_space(3)))
#define GAS __attribute__((address_space(1)))
typedef unsigned short bf16_t;
typedef short bf16x8 __attribute__((ext_vector_type(8)));
typedef float f32x4 __attribute__((ext_vector_type(4)));
typedef float f32x2 __attribute__((ext_vector_type(2)));
typedef unsigned u32x4 __attribute__((ext_vector_type(4)));
typedef unsigned u32x2 __attribute__((ext_vector_type(2)));

constexpr int DM = 1024, NB = 4, SEQ = 8192, LC = 256, DEPTH = 2;
constexpr int NL = NB * SEQ;
constexpr int NC = NB * LC;
constexpr int NT = NL + NC;
constexpr int INW = 4112;
constexpr int NE = 32;
constexpr int MAXT = 296;
constexpr int MAXROWS = MAXT * 256;
constexpr float EPS = 1e-6f;

constexpr size_t MiB = 1u << 20;
constexpr size_t OFF_CTL = 0;
constexpr size_t OFF_ROPE = 64 * 1024;
constexpr size_t OFF_TW = 128 * 1024;
constexpr size_t OFF_F64 = 80 * 1024;
constexpr size_t OFF_F128 = 192 * 1024;
constexpr size_t OFF_F256 = 512 * 1024;
constexpr size_t OFF_MOD = 256 * 1024;
constexpr size_t OFF_TOKE = 1 * MiB;
constexpr size_t OFF_TOKW = OFF_TOKE + 320 * 1024;
constexpr size_t OFF_POSOF = OFF_TOKW + 320 * 1024;
constexpr size_t OFF_ROWTOK = OFF_POSOF + 320 * 1024;
constexpr size_t OFF_TILEE = OFF_ROWTOK + 320 * 1024;
constexpr size_t OFF_DT = 3 * MiB;
constexpr size_t OFF_CS = 5 * MiB + 256 * 1024;
constexpr size_t OFF_HS = 5 * MiB + 512 * 1024;
constexpr size_t OFF_XC = 6 * MiB;
constexpr size_t OFF_XR = 128 * MiB;
constexpr size_t OFF_W = 10 * MiB;
constexpr size_t W_IN = 0, W_GATE = 8 * MiB, W_BR = 12 * MiB, W_O = 16 * MiB, W_13 = 18 * MiB, W_2 = 50 * MiB;
constexpr size_t OFF_H8 = OFF_W + 68 * MiB;
constexpr size_t OFF_H = 128 * MiB;
constexpr size_t OFF_BR = 198 * MiB;
constexpr size_t OFF_PX = 330 * MiB;
constexpr size_t OFF_T = 462 * MiB;
constexpr size_t OFF_V = 528 * MiB;
constexpr size_t OFF_PG = OFF_PX;
constexpr size_t OFF_YBK = 594 * MiB;
constexpr size_t OFF_MYB = OFF_PX;
constexpr size_t OFF_ACT = OFF_PX + 150 * MiB;
constexpr size_t OFF_XBC = 594 * MiB;
constexpr size_t OFF_CI = 644 * MiB;
constexpr size_t WS_END = 649 * MiB;
constexpr int CW_CNT = 0;
constexpr int CW_CUR = 64;
constexpr int CW_NT = 128;

#ifndef REP_D
#define REP_D 1
#endif
#ifndef REP_G
#define REP_G 1
#endif
#ifndef REP_M
#define REP_M 1
#endif
#ifndef REP_W
#define REP_W 1
#endif
#ifndef REP_O
#define REP_O 1
#endif
#ifndef REP_N
#define REP_N 1
#endif
constexpr int LDS_BYTES = 155648;
constexpr int LDS_PARAMS = 155648 - 256;

struct Params { const float* in[27]; float* out; unsigned char* ws; };
enum { I_X = 0, I_C, I_CTX, I_CCTX, I_N1W, I_N2W, I_WADA, I_BADA, I_WIN, I_SINK, I_CONVW, I_CONVB, I_DTB, I_ALOG, I_SSMD, I_SSMNW, I_SCW,
       I_WGATE, I_BGATE, I_WBR, I_WO, I_WROUTER, I_RBIAS, I_W1, I_W3, I_W2, I_FNW };

template <class T> __device__ __forceinline__ GAS T* gp(T* p) { return (GAS T*)p; }
__device__ __forceinline__ float bf2f(unsigned v) { return __uint_as_float(v << 16); }
__device__ __forceinline__ float bflo(unsigned u) { return __uint_as_float(u << 16); }
__device__ __forceinline__ float bfhi(unsigned u) { return __uint_as_float(u & 0xffff0000u); }
__device__ __forceinline__ unsigned f2bf(float f) { unsigned u = __float_as_uint(f); return (u + 0x7fffu + ((u >> 16) & 1u)) >> 16; }
__device__ __forceinline__ unsigned pk2(float lo, float hi) { return f2bf(lo) | (f2bf(hi) << 16); }
__device__ __forceinline__ float clamp_f8(float x) { return fminf(fmaxf(x, -440.f), 440.f); }
__device__ __forceinline__ unsigned pk4_fp8(float a, float b, float c, float d) { int w = 0; w = __builtin_amdgcn_cvt_pk_fp8_f32(a, b, w, false); w = __builtin_amdgcn_cvt_pk_fp8_f32(c, d, w, true); return (unsigned)w; }
__device__ __forceinline__ int q8(float x) { return (int)__builtin_rintf(x) & 255; }
__device__ __forceinline__ unsigned pk4_i8(float a, float b, float c, float d) { return (unsigned)(q8(a) | (q8(b) << 8) | (q8(c) << 16) | (q8(d) << 24)); }
__device__ __forceinline__ float silu_f(float x) { return x * __builtin_amdgcn_rcpf(1.f + __builtin_amdgcn_exp2f(-1.4426950408889634f * x)); }
__device__ __forceinline__ float sigmoid_f(float x) { return __builtin_amdgcn_rcpf(1.f + __builtin_amdgcn_exp2f(-1.4426950408889634f * x)); }
__device__ __forceinline__ float softplus_f(float x) { return fmaxf(x, 0.f) + log1pf(__expf(-fabsf(x))); }
__device__ __forceinline__ float wave_sum(float v) {
#pragma unroll
    for (int o = 1; o < 64; o <<= 1) v += __shfl_xor(v, o);
    return v;
}

template <int H, int BIT, int N> __device__ __forceinline__ void rs_step(float (&v)[N], int lane) {
    const bool up = (lane & BIT) != 0;
#pragma unroll
    for (int j = 0; j < H; ++j) { const float keep = up ? v[j + H] : v[j], send = up ? v[j] : v[j + H]; v[j] = keep + __shfl_xor(send, BIT); }
}
__device__ __forceinline__ float wave_reduce_scatter32(float (&v)[32], int lane) {
    rs_step<16, 32>(v, lane); rs_step<8, 16>(v, lane); rs_step<4, 8>(v, lane); rs_step<2, 4>(v, lane); rs_step<1, 2>(v, lane);
    return v[0] + __shfl_xor(v[0], 1);
}
__device__ __forceinline__ float wave_reduce_scatter16(float (&v)[16], int lane) {
    rs_step<8, 32>(v, lane); rs_step<4, 16>(v, lane); rs_step<2, 8>(v, lane); rs_step<1, 4>(v, lane);
    float r = v[0]; r += __shfl_xor(r, 2); r += __shfl_xor(r, 1); return r;
}

namespace pg8 {
constexpr int BM = 256, BK = 64, HALF = 128, HTB = HALF * BK * 2, STAGE_BYTES = 8 * HTB, NXCD = 8, WGM = 8;
__device__ __forceinline__ int lds_byte(int r, int c) { const int st = (r >> 4) * 2 + (c >> 5), rr = r & 15, cc = c & 31, ob = rr * 64 + cc * 2; return st * 1024 + (ob ^ (((ob >> 9) & 1) << 5)); }
__device__ __forceinline__ void stage_rc(int b, int& R, int& C) { const int st = b / 1024, sb = b % 1024, swz = sb ^ (((sb >> 9) & 1) << 5); R = (st >> 1) * 16 + swz / 64; C = (st & 1) * 32 + (swz % 64) / 2; }
__device__ __forceinline__ int perm32(int rho) { const int n = rho >> 4, i = rho & 15; return 8 * (i >> 2) + 4 * n + (i & 3); }
struct Unit { int pm, pn, aux; };

struct DenseOrder {
    int nM, nN, nwg, G, c;
    __device__ void init(int nM_, int nN_, int G_, int c_) { nM = nM_; nN = nN_; nwg = nM * nN; G = G_; c = c_; }
    __device__ bool next(int i, Unit& u) const {
        const long L = (long)i * G + c; if (L >= nwg) return false;
        int wgid = (int)L; { const int q = nwg / NXCD, r = nwg % NXCD, xcd = wgid % NXCD, off = wgid / NXCD; wgid = (xcd < r ? xcd * (q + 1) : r * (q + 1) + (xcd - r) * q) + off; }
        const int nig = WGM * nN, gid = wgid / nig, fm = gid * WGM, gsz = (nM - fm) < WGM ? (nM - fm) : WGM;
        u.pm = fm + ((wgid % nig) % gsz); u.pn = (wgid % nig) / gsz; u.aux = 0; return true;
    }
};

typedef int i32x8 __attribute__((ext_vector_type(8)));
typedef int i32x4 __attribute__((ext_vector_type(4)));
template <class Epi, class Sched, bool GATHER, int MODE = 0>
__device__ __forceinline__ void gemm_phase(LAS unsigned char* lds, const int nt, const int lda_b, const int ldb_b, const Sched& S, Epi& E, const int sc_w = 0x7F7F7F7F, const int sc_x = 0x7F7F7F7F) {
    constexpr bool FP8 = (MODE == 1), I8 = (MODE == 2);
    int tid_ = threadIdx.x; asm volatile("" : "+v"(tid_));
    const int tid = tid_, wid = __builtin_amdgcn_readfirstlane(tid >> 6), lane = tid & 63, wr = wid >> 2, wc = wid & 3, fr = lane & 15, fq = lane >> 4;
    unsigned vA0[2], vA1[2], vB[2], nA0[2], nA1[2]; int Rst[2], Cst[2];
#pragma unroll
    for (int i = 0; i < 2; ++i) { int R, C; stage_rc(tid * 16 + i * 8192, R, C); const int Rb = Epi::WCONT ? ((R >> 5) * 64 + perm32(R & 31)) : Epi::PERM ? ((R & ~31) + perm32(R & 31)) : R; Rst[i] = R; Cst[i] = C;
        vA0[i] = (unsigned)(R * lda_b + C * 2); vA1[i] = vA0[i] + (unsigned)(HALF * lda_b); vB[i] = (unsigned)(Rb * ldb_b + C * 2); nA0[i] = vA0[i]; nA1[i] = vA1[i]; }
    const size_t kstep = (size_t)(BK * 2);
    const size_t hstepB = (size_t)(Epi::WCONT ? 32 : HALF) * ldb_b;
    const unsigned ldsw = (unsigned)wid * 1024u;
    const int aoff = lds_byte(wr * 64 + fr, fq * 8), boff = lds_byte(wc * 32 + fr, fq * 8);
#define PG8_SA(b, h) (((b) * 2 + (h)) * HTB)
#define PG8_SB(b, h) ((4 + (b) * 2 + (h)) * HTB)
#define PG8_STAGE(bufoff, gbase, voff) do { _Pragma("unroll") for (int _i = 0; _i < 2; ++_i) \
        __builtin_amdgcn_global_load_lds((const GAS unsigned*)((const GAS char*)(gbase) + (voff)[_i]), (LAS unsigned*)(lds + (bufoff) + ldsw + _i * 8192), 16, 0, 0); } while (0)
#define PG8_LD32(addr) __builtin_bit_cast(i32x8, __builtin_shufflevector(*(const LAS bf16x8*)(addr), *(const LAS bf16x8*)((addr) + 1024), 0, 1, 2, 3, 4, 5, 6, 7, 8, 9, 10, 11, 12, 13, 14, 15))
#define PG8_LDA(dst, b, h) do { if constexpr (FP8) { _Pragma("unroll") for (int m = 0; m < 4; ++m) dst##8[m] = PG8_LD32(lds + PG8_SA(b, h) + aoff + m * 2048); } \
        else { _Pragma("unroll") for (int m = 0; m < 4; ++m) _Pragma("unroll") for (int k = 0; k < 2; ++k) dst[m][k] = *(const LAS bf16x8*)(lds + PG8_SA(b, h) + aoff + m * 2048 + k * 1024); } } while (0)
#define PG8_LDB(dst, b, h) do { if constexpr (FP8) { _Pragma("unroll") for (int n = 0; n < 2; ++n) dst##8[n] = PG8_LD32(lds + PG8_SB(b, h) + boff + n * 2048); } \
        else { _Pragma("unroll") for (int n = 0; n < 2; ++n) _Pragma("unroll") for (int k = 0; k < 2; ++k) dst[n][k] = *(const LAS bf16x8*)(lds + PG8_SB(b, h) + boff + n * 2048 + k * 1024); } } while (0)
#define PG8_MMA(ai, bj, At, Bt) do { __builtin_amdgcn_s_setprio(1); \
        if constexpr (FP8) { _Pragma("unroll") for (int m = 0; m < 4; ++m) _Pragma("unroll") for (int n = 0; n < 2; ++n) \
            asm volatile("v_mfma_scale_f32_16x16x128_f8f6f4 %0, %1, %2, %0, %3, %4 op_sel_hi:[0,0,0]" : "+v"(acc[ai][bj][m][n]) : "v"(Bt##8[n]), "v"(At##8[m]), "v"(vsw), "v"(vsx)); } \
        else if constexpr (I8) { _Pragma("unroll") for (int m = 0; m < 4; ++m) _Pragma("unroll") for (int n = 0; n < 2; ++n) _Pragma("unroll") for (int k = 0; k < 2; ++k) \
            acc[ai][bj][m][n] = __builtin_bit_cast(f32x4, __builtin_amdgcn_mfma_i32_16x16x64_i8(__builtin_bit_cast(i32x4, Bt[n][k]), __builtin_bit_cast(i32x4, At[m][k]), __builtin_bit_cast(i32x4, acc[ai][bj][m][n]), 0, 0, 0)); } \
        else { _Pragma("unroll") for (int m = 0; m < 4; ++m) _Pragma("unroll") for (int n = 0; n < 2; ++n) _Pragma("unroll") for (int k = 0; k < 2; ++k) \
            acc[ai][bj][m][n] = __builtin_amdgcn_mfma_f32_16x16x32_bf16(Bt[n][k], At[m][k], acc[ai][bj][m][n], 0, 0, 0); } \
        __builtin_amdgcn_s_setprio(0); } while (0)
#define PG8_WAIT_V(n) asm volatile("s_waitcnt vmcnt(" #n ")" ::: "memory")
#define PG8_WAIT_L(n) asm volatile("s_waitcnt lgkmcnt(" #n ")" ::: "memory")
#define PG8_BAR __builtin_amdgcn_s_barrier()
#define PG8_SCHED __builtin_amdgcn_sched_barrier(0)
    int vsw = sc_w, vsx = sc_x; asm volatile("" : "+v"(vsw), "+v"(vsx));
    Unit cur, nxt; int ui = 0;
    if (!S.next(0, cur)) return;
    if constexpr (GATHER) { const GAS int* ri = S.rowidx(cur);
#pragma unroll
        for (int i = 0; i < 2; ++i) { vA0[i] = (unsigned)(ri[Rst[i]] * lda_b + Cst[i] * 2); vA1[i] = (unsigned)(ri[HALF + Rst[i]] * lda_b + Cst[i] * 2); } }
    f32x4 acc[2][2][4][2];
#pragma unroll
    for (int a = 0; a < 2; ++a)
#pragma unroll
        for (int b = 0; b < 2; ++b)
#pragma unroll
            for (int m = 0; m < 4; ++m)
#pragma unroll
                for (int n = 0; n < 2; ++n) acc[a][b][m][n] = (f32x4){0.f, 0.f, 0.f, 0.f};
    bf16x8 At[4][2], B0[2][2], B1[2][2]; i32x8 At8[4], B08[2], B18[2];
    const GAS char* cA = S.abase(cur); const GAS char* cB = S.bbase(cur);
    PG8_STAGE(PG8_SB(0, 0), cB, vB); PG8_STAGE(PG8_SB(0, 1), cB + hstepB, vB); PG8_STAGE(PG8_SA(0, 0), cA, vA0); PG8_STAGE(PG8_SA(0, 1), cA, vA1);
    if (wr == 1) PG8_BAR;
    PG8_WAIT_V(2); PG8_BAR;
    PG8_STAGE(PG8_SB(1, 0), cB + kstep, vB); PG8_STAGE(PG8_SA(1, 0), cA + kstep, vA0); PG8_STAGE(PG8_SB(1, 1), cB + hstepB + kstep, vB);
    PG8_WAIT_V(6); PG8_BAR;
    for (;;) {
        const bool has_next = S.next(ui + 1, nxt);
        const GAS char* nA = has_next ? S.abase(nxt) : cA; const GAS char* nB = has_next ? S.bbase(nxt) : cB;
        if constexpr (GATHER) { if (has_next) { const GAS int* ri = S.rowidx(nxt);
#pragma unroll
            for (int i = 0; i < 2; ++i) { nA0[i] = (unsigned)(ri[Rst[i]] * lda_b + Cst[i] * 2); nA1[i] = (unsigned)(ri[HALF + Rst[i]] * lda_b + Cst[i] * 2); } }
            else {
#pragma unroll
                for (int i = 0; i < 2; ++i) { nA0[i] = vA0[i]; nA1[i] = vA1[i]; } } }
#pragma unroll 1
        for (int t = 0; t < nt; t += 2) {
            const bool last = (t == nt - 2);
            const bool skip = (t == 0) && (ui > 0);
            const GAS char* a1 = cA + (size_t)(t + 1) * kstep;
            const GAS char* a2 = last ? nA : cA + (size_t)(t + 2) * kstep; const GAS char* b2 = last ? nB : cB + (size_t)(t + 2) * kstep;
            const GAS char* a3 = a2 + kstep; const GAS char* b3 = b2 + kstep;
            unsigned wA0[2], wA1[2];
#pragma unroll
            for (int i = 0; i < 2; ++i) { wA0[i] = (GATHER && last) ? nA0[i] : vA0[i]; wA1[i] = (GATHER && last) ? nA1[i] : vA1[i]; }
            PG8_LDB(B0, 0, 0); PG8_LDB(B1, 0, 1); PG8_SCHED; PG8_LDA(At, 0, 0); if (!skip) { PG8_STAGE(PG8_SA(1, 1), a1, vA1); PG8_WAIT_V(8); }
            PG8_WAIT_L(0); PG8_BAR; PG8_MMA(0, 0, At, B0); PG8_MMA(0, 1, At, B1); PG8_BAR; PG8_SCHED;
            PG8_LDA(At, 0, 1); PG8_STAGE(PG8_SB(0, 0), b2, vB); PG8_STAGE(PG8_SB(0, 1), b2 + hstepB, vB); PG8_STAGE(PG8_SA(0, 0), a2, wA0);
            if (!skip) PG8_WAIT_V(8); PG8_WAIT_L(0); PG8_BAR; PG8_MMA(1, 0, At, B0); PG8_MMA(1, 1, At, B1); PG8_BAR; PG8_SCHED;
            PG8_LDB(B0, 1, 0); PG8_LDB(B1, 1, 1); PG8_SCHED; PG8_LDA(At, 1, 0); PG8_STAGE(PG8_SA(0, 1), a2, wA1);
            if (!skip) PG8_WAIT_V(8); PG8_WAIT_L(0); PG8_BAR; PG8_MMA(0, 0, At, B0); PG8_MMA(0, 1, At, B1); PG8_BAR; PG8_SCHED;
            PG8_LDA(At, 1, 1); PG8_STAGE(PG8_SB(1, 0), b3, vB); PG8_STAGE(PG8_SB(1, 1), b3 + hstepB, vB); PG8_STAGE(PG8_SA(1, 0), a3, wA0);
            if (!skip) PG8_WAIT_V(8); PG8_WAIT_L(0); PG8_BAR; PG8_MMA(1, 0, At, B0); PG8_MMA(1, 1, At, B1); PG8_BAR; PG8_SCHED;
        }
        { unsigned wA1[2];
#pragma unroll
          for (int i = 0; i < 2; ++i) wA1[i] = GATHER ? nA1[i] : vA1[i];
          PG8_STAGE(PG8_SA(1, 1), nA + kstep, wA1); }
        if (wr == 0) PG8_BAR;
        if constexpr (FP8) asm volatile("s_nop 15\n\ts_nop 15" ::: "memory");
        if constexpr (I8) {
            const GAS float* cs = S.colscale(cur) + wc * (Epi::WCONT ? 64 : 32); const GAS float* rsb = S.rowscale();
            f32x4 c0[2][2];
#pragma unroll
            for (int bj = 0; bj < 2; ++bj)
#pragma unroll
                for (int n = 0; n < 2; ++n) c0[bj][n] = *(const GAS f32x4*)(cs + bj * (Epi::WCONT ? 32 : HALF) + (Epi::PERM ? (8 * fq + 4 * n) : (16 * n + 4 * fq)));
#pragma unroll
            for (int ai = 0; ai < 2; ++ai)
#pragma unroll
                for (int m = 0; m < 4; ++m) { const int lr = ai * HALF + wr * 64 + m * 16 + fr; int grow;
                    if constexpr (GATHER) grow = S.rowidx(cur)[lr]; else grow = S.rowbase(cur) + lr;
                    const float rsv = rsb[grow];
#pragma unroll
                    for (int bj = 0; bj < 2; ++bj)
#pragma unroll
                        for (int n = 0; n < 2; ++n) { const f32x4 t = __builtin_convertvector(__builtin_bit_cast(i32x4, acc[ai][bj][m][n]), f32x4) * rsv; acc[ai][bj][m][n] = t * c0[bj][n]; } }
            asm volatile("" ::: "memory"); __builtin_amdgcn_sched_barrier(0);
        }
        PG8_WAIT_V(0);
        E(acc, cur, wr, wc, fr, fq);
        if (!has_next) break;
#pragma unroll
        for (int a = 0; a < 2; ++a)
#pragma unroll
            for (int b = 0; b < 2; ++b)
#pragma unroll
                for (int m = 0; m < 4; ++m)
#pragma unroll
                    for (int n = 0; n < 2; ++n) acc[a][b][m][n] = (f32x4){0.f, 0.f, 0.f, 0.f};
        cur = nxt; cA = nA; cB = nB; ++ui;
        if constexpr (GATHER) {
#pragma unroll
            for (int i = 0; i < 2; ++i) { vA0[i] = nA0[i]; vA1[i] = nA1[i]; } }
        if (wr == 1) PG8_BAR;
    }
    PG8_WAIT_V(0);
    PG8_BAR;
#undef PG8_SA
#undef PG8_SB
#undef PG8_STAGE
#undef PG8_LDA
#undef PG8_LDB
#undef PG8_MMA
#undef PG8_LD32
#undef PG8_WAIT_V
#undef PG8_WAIT_L
#undef PG8_BAR
#undef PG8_SCHED
}

typedef __bf16 bf16x2_t __attribute__((ext_vector_type(2)));
__device__ __forceinline__ unsigned cvt_pk_bf16(float lo, float hi) { f32x2 v = {lo, hi}; bf16x2_t b = __builtin_convertvector(v, bf16x2_t); return __builtin_bit_cast(unsigned, b); }

struct EpiStore {
    static constexpr bool PERM = true, WCONT = true;
    GAS bf16_t* O; int ldc; int rope; const GAS f32x2* ropetab; int row_off; LAS unsigned char* stg;
    __device__ __forceinline__ void operator()(const f32x4 (&acc)[2][2][4][2], const Unit& u, int wr, int wc, int fr, int fq) const {
        const int lane = fq * 16 + fr;
        LAS unsigned char* sb = stg + (wr * 4 + wc) * 2304;
        LAS unsigned char* wp = sb + fr * 144 + fq * 16;
        const LAS unsigned char* rp = sb + (lane >> 3) * 144 + (lane & 7) * 16;
        const int row0 = row_off + u.pm * BM + wr * 64; const int colw = u.pn * BM + wc * 64;
        GAS bf16_t* op = O + (size_t)(row0 + (lane >> 3)) * ldc + colw + (lane & 7) * 8;
#pragma unroll
        for (int ai = 0; ai < 2; ++ai)
#pragma unroll
            for (int m = 0; m < 4; ++m) { const int row = row0 + ai * HALF + m * 16 + fr;
#pragma unroll
                for (int bj = 0; bj < 2; ++bj) { f32x4 v0 = acc[ai][bj][m][0], v1 = acc[ai][bj][m][1];
                    if (rope && row < NL && (colw + bj * 32) < 640) {
                        const int l = row & (SEQ - 1); const int pos = bj ? (l & 63) : (l >> 6);
                        const GAS f32x2* tp = ropetab + pos * 16 + 4 * fq;
                        const f32x2 cs0 = tp[0], cs1 = tp[1], cs2 = tp[2], cs3 = tp[3];
                        f32x4 r0, r1;
                        r0[0] = v0[0] * cs0.x - v0[1] * cs0.y; r0[1] = v0[1] * cs0.x + v0[0] * cs0.y;
                        r0[2] = v0[2] * cs1.x - v0[3] * cs1.y; r0[3] = v0[3] * cs1.x + v0[2] * cs1.y;
                        r1[0] = v1[0] * cs2.x - v1[1] * cs2.y; r1[1] = v1[1] * cs2.x + v1[0] * cs2.y;
                        r1[2] = v1[2] * cs3.x - v1[3] * cs3.y; r1[3] = v1[3] * cs3.x + v1[2] * cs3.y;
                        v0 = r0; v1 = r1;
                    }
                    u32x4 w; w.x = cvt_pk_bf16(v0[0], v0[1]); w.y = cvt_pk_bf16(v0[2], v0[3]); w.z = cvt_pk_bf16(v1[0], v1[1]); w.w = cvt_pk_bf16(v1[2], v1[3]);
                    *(LAS u32x4*)(wp + bj * 64) = w; }
                __builtin_amdgcn_wave_barrier();
                const u32x4 q0 = *(const LAS u32x4*)rp, q1 = *(const LAS u32x4*)(rp + 8 * 144);
                __builtin_amdgcn_wave_barrier();
                GAS bf16_t* o = op + (size_t)(ai * HALF + m * 16) * ldc;
                __builtin_nontemporal_store(q0, (GAS u32x4*)o); __builtin_nontemporal_store(q1, (GAS u32x4*)(o + (size_t)8 * ldc)); }
    }
};
struct EpiGate {
    static constexpr bool PERM = true, WCONT = true;
    const GAS bf16_t* P; const GAS float* bgate; GAS bf16_t* M; LAS unsigned char* stg;
    __device__ __forceinline__ void operator()(const f32x4 (&acc)[2][2][4][2], const Unit& u, int wr, int wc, int fr, int fq) const {
        const int lane = fq * 16 + fr;
        LAS unsigned char* grp = stg + wr * 9216;
        LAS unsigned char* wp = grp + wc * 2304 + fr * 144 + fq * 16;
        const int rr = 4 * wc + (lane >> 4), dq = lane & 15;
        const LAS unsigned char* rp = grp + rr * 144 + dq * 8;
        const int row0 = u.pm * BM + wr * 64;
        const GAS bf16_t* pp = P + (size_t)(row0 + fr) * 4096 + wc * 1024 + u.pn * 64 + 8 * fq;
        GAS bf16_t* mp = M + (size_t)(row0 + rr) * 1024 + u.pn * 64 + 4 * dq;
        f32x4 bg[2][2];
#pragma unroll
        for (int bj = 0; bj < 2; ++bj)
#pragma unroll
            for (int nn = 0; nn < 2; ++nn) bg[bj][nn] = *(const GAS f32x4*)(bgate + wc * 1024 + u.pn * 64 + bj * 32 + 8 * fq + 4 * nn);
        u32x4 pnx[2];
#pragma unroll
        for (int bj = 0; bj < 2; ++bj) pnx[bj] = *(const GAS u32x4*)(pp + bj * 32);
#pragma unroll
        for (int st = 0; st < 8; ++st) { const int ai = st >> 2, m = st & 3;
            u32x4 pc[2];
#pragma unroll
            for (int bj = 0; bj < 2; ++bj) pc[bj] = pnx[bj];
            if (st + 1 < 8) { const int a2 = (st + 1) >> 2, m2 = (st + 1) & 3;
#pragma unroll
                for (int bj = 0; bj < 2; ++bj) pnx[bj] = *(const GAS u32x4*)(pp + (size_t)(a2 * HALF + m2 * 16) * 4096 + bj * 32); }
#pragma unroll
            for (int bj = 0; bj < 2; ++bj) { const f32x4 a0 = acc[ai][bj][m][0] + bg[bj][0], a1 = acc[ai][bj][m][1] + bg[bj][1]; const u32x4 pq = pc[bj];
                u32x4 w; w.x = cvt_pk_bf16(sigmoid_f(a0[0]) * bflo(pq.x), sigmoid_f(a0[1]) * bfhi(pq.x)); w.y = cvt_pk_bf16(sigmoid_f(a0[2]) * bflo(pq.y), sigmoid_f(a0[3]) * bfhi(pq.y));
                w.z = cvt_pk_bf16(sigmoid_f(a1[0]) * bflo(pq.z), sigmoid_f(a1[1]) * bfhi(pq.z)); w.w = cvt_pk_bf16(sigmoid_f(a1[2]) * bflo(pq.w), sigmoid_f(a1[3]) * bfhi(pq.w));
                *(LAS u32x4*)(wp + bj * 64) = w; }
            asm volatile("s_waitcnt lgkmcnt(0)" ::: "memory"); __builtin_amdgcn_s_barrier(); asm volatile("" ::: "memory");
            f32x4 sm = {0.f, 0.f, 0.f, 0.f};
#pragma unroll
            for (int w4 = 0; w4 < 4; ++w4) { const u32x2 t = *(const LAS u32x2*)(rp + w4 * 2304); sm[0] += bflo(t.x); sm[1] += bfhi(t.x); sm[2] += bflo(t.y); sm[3] += bfhi(t.y); }
            u32x2 o; o.x = cvt_pk_bf16(sm[0], sm[1]); o.y = cvt_pk_bf16(sm[2], sm[3]);
            *(GAS u32x2*)(mp + (size_t)(ai * HALF + m * 16) * 1024) = o;
            asm volatile("s_waitcnt lgkmcnt(0)" ::: "memory"); __builtin_amdgcn_s_barrier(); asm volatile("" ::: "memory");
        }
    }
};
struct EpiResid {
    static constexpr bool PERM = false, WCONT = false;
    GAS bf16_t* xr; const GAS float* sl; const GAS float* sc; int srcf32; const GAS float* mod;
    __device__ __forceinline__ void operator()(const f32x4 (&acc)[2][2][4][2], const Unit& u, int wr, int wc, int fr, int fq) const {
        const int row0 = u.pm * BM + wr * 64 + fr; const int col0 = u.pn * BM + wc * 32 + 4 * fq;
        const int mrow = (u.pm < 128) ? (u.pm >> 5) : 4;
        const GAS float* mp = mod + (size_t)mrow * 6144 + 2 * 1024;
#pragma unroll
        for (int bj = 0; bj < 2; ++bj)
#pragma unroll
            for (int n = 0; n < 2; ++n) { const int c = col0 + bj * HALF + n * 16; const f32x4 g = *(const GAS f32x4*)(mp + c);
#pragma unroll
                for (int ai = 0; ai < 2; ++ai)
#pragma unroll
                    for (int m = 0; m < 4; ++m) { const int row = row0 + ai * HALF + m * 16;
                        f32x4 xv;
                        if (srcf32) xv = *(const GAS f32x4*)(((row < NL) ? sl + (size_t)row * 1024 : sc + (size_t)(row - NL) * 1024) + c);
                        else { const u32x2 w = *(const GAS u32x2*)(xr + (size_t)row * 1024 + c); xv = (f32x4){bflo(w.x), bfhi(w.x), bflo(w.y), bfhi(w.y)}; }
                        xv = xv + g * acc[ai][bj][m][n];
                        u32x2 o; o.x = cvt_pk_bf16(xv[0], xv[1]); o.y = cvt_pk_bf16(xv[2], xv[3]);
                        *(GAS u32x2*)(xr + (size_t)row * 1024 + c) = o; } }
    }
};
struct EpiSwiglu {
    static constexpr bool PERM = true, WCONT = false;
    GAS unsigned char* act;
    __device__ __forceinline__ void operator()(const f32x4 (&acc)[2][2][4][2], const Unit& u, int wr, int wc, int fr, int fq) const {
        const int row0 = u.pm * BM + wr * 64 + fr; const int col0 = u.pn * 128 + wc * 32 + 8 * fq;
#pragma unroll
        for (int ai = 0; ai < 2; ++ai)
#pragma unroll
            for (int m = 0; m < 4; ++m) { const int row = row0 + ai * HALF + m * 16;
                const f32x4 a0 = acc[ai][0][m][0], a1 = acc[ai][0][m][1], b0 = acc[ai][1][m][0] * 8.f, b1 = acc[ai][1][m][1] * 8.f;
                u32x2 w; w.x = pk4_fp8(silu_f(a0[0]) * b0[0], silu_f(a0[1]) * b0[1], silu_f(a0[2]) * b0[2], silu_f(a0[3]) * b0[3]);
                w.y = pk4_fp8(silu_f(a1[0]) * b1[0], silu_f(a1[1]) * b1[1], silu_f(a1[2]) * b1[2], silu_f(a1[3]) * b1[3]);
                *(GAS u32x2*)(act + (size_t)row * 512 + col0) = w; }
    }
};
struct SchedDense { DenseOrder o; const GAS char* A; const GAS char* Bt; size_t a_tile, b_tile; size_t a_colgrp; int colgrp_shift; const GAS float* cs; const GAS float* rs;
    __device__ __forceinline__ const GAS float* colscale(const Unit& u) const { return cs + u.pn * 256; }
    __device__ __forceinline__ const GAS float* rowscale() const { return rs; }
    __device__ __forceinline__ int rowbase(const Unit& u) const { return u.pm * 256; }
    __device__ __forceinline__ bool next(int i, Unit& u) const { return o.next(i, u); }
    __device__ __forceinline__ const GAS char* abase(const Unit& u) const { return A + (size_t)u.pm * a_tile + (size_t)(u.pn >> colgrp_shift) * a_colgrp; }
    __device__ __forceinline__ const GAS char* bbase(const Unit& u) const { return Bt + (size_t)u.pn * b_tile; }
    __device__ __forceinline__ const GAS int* rowidx(const Unit&) const { return nullptr; }
};
struct SchedMoe {
    int G, c; const GAS char* A; const GAS char* Bt; const GAS int* rowtok; const GAS int* xinfo; size_t a_tile, e_stride, b_tile; const GAS float* cs; const GAS float* rs;
    __device__ __forceinline__ const GAS float* colscale(const Unit& u) const { return cs + u.aux * 1024 + u.pn * 256; }
    __device__ __forceinline__ const GAS float* rowscale() const { return rs; }
    __device__ __forceinline__ int rowbase(const Unit& u) const { return u.pm * 256; }
    __device__ __forceinline__ bool next(int i, Unit& u) const {
        const int x = c & 7, j = c >> 3, per = G >> 3; const int k = i * per + j; const GAS int* xi = xinfo + x * 16;
        const int p1 = xi[1], p2 = xi[2], p3 = xi[3], p4 = xi[4];
        if (k >= 4 * p4) return false;
        const int tl = k >> 2; const int q = (tl >= p3) ? 3 : (tl >= p2) ? 2 : (tl >= p1) ? 1 : 0; const int pq = (q == 3) ? p3 : (q == 2) ? p2 : (q == 1) ? p1 : 0;
        u.pm = xi[8 + q] + (tl - pq); u.pn = k & 3; u.aux = x + 8 * q; return true; }
    __device__ __forceinline__ const GAS char* abase(const Unit& u) const { return A + (size_t)u.pm * a_tile; }
    __device__ __forceinline__ const GAS char* bbase(const Unit& u) const { return Bt + (size_t)u.aux * e_stride + (size_t)u.pn * b_tile; }
    __device__ __forceinline__ const GAS int* rowidx(const Unit& u) const { return rowtok + u.pm * 256; }
};
}

struct Ctx {
    LAS unsigned char* lds; int tid, lane, wave, gw, ngw, bid, nblk, vbid;
    const LAS Params* p;
};

__device__ __forceinline__ void ph_tables(const Ctx& c, GAS unsigned char* ws) {
    const int gt = c.bid * 512 + c.tid, ngt = c.nblk * 512;
    GAS f32x2* rope = (GAS f32x2*)(ws + OFF_ROPE); GAS f32x2* tw = (GAS f32x2*)(ws + OFF_TW);
    for (int i = gt; i < 2048; i += ngt) { const int pos = i >> 4, fi = i & 15; const float invf = powf(10000.f, -(float)fi / 16.f); const float a = (float)pos * invf; rope[i] = (f32x2){cosf(a), sinf(a)}; }
    for (int i = gt; i < 8192; i += ngt) { const float x = (float)i / 4096.f; tw[i] = (f32x2){cospif(x), sinpif(x)}; }
    GAS bf16_t* f64 = (GAS bf16_t*)(ws + OFF_F64); GAS bf16_t* f128 = (GAS bf16_t*)(ws + OFF_F128);
    for (int i = gt; i < 4096; i += ngt) { const int m = i >> 6, cc = i & 63; const float x = (float)((m * cc) & 63) / 32.f; f64[i] = (bf16_t)f2bf(cospif(x)); f64[4096 + i] = (bf16_t)f2bf(sinpif(x)); }
    for (int i = gt; i < 16384; i += ngt) { const int k = i >> 7, l = i & 127; const float x = (float)((k * l) & 127) / 64.f; f128[i] = (bf16_t)f2bf(cospif(x)); f128[16384 + i] = (bf16_t)f2bf(sinpif(x)); }
    GAS bf16_t* f256 = (GAS bf16_t*)(ws + OFF_F256);
    for (int i = gt; i < 65536; i += ngt) { const int k = i >> 8, l = i & 255; const float x = (float)((k * l) & 255) / 128.f; f256[i] = (bf16_t)f2bf(cospif(x)); f256[65536 + i] = (bf16_t)f2bf(sinpif(x)); }
    GAS unsigned* ctl = (GAS unsigned*)(ws + OFF_CTL);
    for (int i = gt; i < 256; i += ngt) ctl[i] = 0u;
    GAS unsigned* barw = (GAS unsigned*)(ws + 16 * 1024);
    for (int i = gt; i < 3456; i += ngt) barw[i] = 0u;
}

__device__ __forceinline__ void ph_mod(const Ctx& c, GAS unsigned char* ws) {
    const LAS Params& P = *c.p;
    LAS float* sc = (LAS float*)c.lds;
    LAS float* red = sc + 5 * 1024;
    for (int i = c.tid; i < 5 * 1024; i += 512) { const float v = (i < 4096) ? gp(P.in[I_C])[i] : gp(P.in[I_CCTX])[i - 4096]; sc[i] = silu_f(v); }
    __syncthreads();
    GAS float* MOD = (GAS float*)(ws + OFF_MOD);
    for (int grp = c.bid; grp < 512; grp += c.nblk) {
        const int L = grp >> 8, j0 = (grp & 255) * 24;
        const GAS float* W = gp(P.in[I_WADA]) + (size_t)L * 1024 * 6144;
        const int kk = c.tid / 24, jj = c.tid % 24;
        float a0 = 0.f, a1 = 0.f, a2 = 0.f, a3 = 0.f, a4 = 0.f;
        if (kk < 21) for (int k = kk; k < 1024; k += 21) { const float w = W[(size_t)k * 6144 + j0 + jj]; a0 += sc[k] * w; a1 += sc[1024 + k] * w; a2 += sc[2048 + k] * w; a3 += sc[3072 + k] * w; a4 += sc[4096 + k] * w; }
        if (kk < 21) { LAS float* r = red + (kk * 24 + jj) * 5; r[0] = a0; r[1] = a1; r[2] = a2; r[3] = a3; r[4] = a4; }
        __syncthreads();
        if (c.tid < 120) { const int j = c.tid % 24, r = c.tid / 24; float s = gp(P.in[I_BADA])[L * 6144 + j0 + j];
            for (int q = 0; q < 21; ++q) s += red[(q * 24 + j) * 5 + r];
            MOD[((size_t)L * 5 + r) * 6144 + j0 + j] = s; }
        __syncthreads();
    }
}

__device__ __forceinline__ int wrow_in(int cidx) {
    if (cidx < 640) { const int hb = cidx & ~63, d = cidx & 63; return hb + ((d < 32) ? 2 * d : 2 * (d - 32) + 1); }
    return cidx;
}
__device__ __forceinline__ int wrow_gate(int cidx) {
    const int n = cidx >> 10, d = cidx & 1023, dl = d & 63;
    return (d >> 6) * 256 + 64 * n + dl;
}
template <int MAP, bool F8 = false>
__device__ __forceinline__ void transpose_item(const GAS float* W, int ldw, int K, GAS void* WTv, int row_base, LAS float* scr, int kb, int nb, int lane) {
    const int k0 = 64 * kb, n0 = 32 * nb;
    { f32x4 t[8];
#pragma unroll
      for (int i = 0; i < 8; ++i) t[i] = *(const GAS f32x4*)(W + (size_t)(k0 + 8 * i + (lane >> 3)) * ldw + n0 + 4 * (lane & 7));
#pragma unroll
      for (int i = 0; i < 8; ++i) { LAS float* d = scr + (8 * i + (lane >> 3)) * 33 + 4 * (lane & 7); d[0] = t[i].x; d[1] = t[i].y; d[2] = t[i].z; d[3] = t[i].w; } }
    asm volatile("s_waitcnt lgkmcnt(0)" ::: "memory");
    const int cch = lane & 7;
#pragma unroll
    for (int j = 0; j < 4; ++j) { const int n = (lane >> 3) + 8 * j; const LAS float* s = scr + (8 * cch) * 33 + n;
        const int cidx = n0 + n; int r;
        if (MAP == 1) r = wrow_in(cidx); else if (MAP == 2) r = wrow_gate(cidx); else if (MAP == 3) r = (cidx >> 7) * 256 + (cidx & 127); else r = cidx;
        if (F8) { u32x2 o; o.x = pk4_fp8(s[0 * 33] * 32.f, s[1 * 33] * 32.f, s[2 * 33] * 32.f, s[3 * 33] * 32.f); o.y = pk4_fp8(s[4 * 33] * 32.f, s[5 * 33] * 32.f, s[6 * 33] * 32.f, s[7 * 33] * 32.f);
            *(GAS u32x2*)((GAS unsigned char*)WTv + (size_t)(row_base + r) * K + k0 + 8 * cch) = o; }
        else { u32x4 o; o.x = pk2(s[0 * 33], s[1 * 33]); o.y = pk2(s[2 * 33], s[3 * 33]); o.z = pk2(s[4 * 33], s[5 * 33]); o.w = pk2(s[6 * 33], s[7 * 33]);
            *(GAS u32x4*)((GAS bf16_t*)WTv + (size_t)(row_base + r) * K + k0 + 8 * cch) = o; } }
    asm volatile("s_waitcnt lgkmcnt(0)" ::: "memory");
}
template <int MAP> __device__ __forceinline__ int strip_row(int cidx) {
    if (MAP == 1) return wrow_in(cidx); else if (MAP == 2) return wrow_gate(cidx); else if (MAP == 3) return (cidx >> 7) * 256 + (cidx & 127); else return cidx;
}
template <int MAP>
__device__ __forceinline__ void strip_i8(const GAS float* W, int ldw, int K, GAS unsigned char* WT, GAS float* CS, int row_base, LAS float* scr, int nb, int lane) {
    const int n0 = 32 * nb, r8 = lane >> 3, c4 = lane & 7;
    const GAS float* wp = W + (size_t)r8 * ldw + n0 + 4 * c4;
    f32x4 m4 = {0.f, 0.f, 0.f, 0.f};
    for (int k = 0; k < K; k += 128) {
        f32x4 v[16];
#pragma unroll
        for (int u = 0; u < 16; ++u) v[u] = *(const GAS f32x4*)(wp + (size_t)(k + 8 * u) * ldw);
#pragma unroll
        for (int u = 0; u < 16; ++u) { m4.x = fmaxf(m4.x, fabsf(v[u].x)); m4.y = fmaxf(m4.y, fabsf(v[u].y)); m4.z = fmaxf(m4.z, fabsf(v[u].z)); m4.w = fmaxf(m4.w, fabsf(v[u].w)); }
    }
#pragma unroll
    for (int o = 8; o < 64; o <<= 1) { m4.x = fmaxf(m4.x, __shfl_xor(m4.x, o)); m4.y = fmaxf(m4.y, __shfl_xor(m4.y, o)); m4.z = fmaxf(m4.z, __shfl_xor(m4.z, o)); m4.w = fmaxf(m4.w, __shfl_xor(m4.w, o)); }
    LAS float* invs = scr + 64 * 33;
    if (lane < 8) {
#pragma unroll
        for (int e = 0; e < 4; ++e) { const float m = fmaxf(m4[e], 1e-20f); invs[4 * c4 + e] = 127.f / m; CS[row_base + strip_row<MAP>(n0 + 4 * c4 + e)] = m * (1.f / 127.f); } }
    const int nk = K / 64; f32x4 t[8];
#pragma unroll
    for (int i = 0; i < 8; ++i) t[i] = *(const GAS f32x4*)(wp + (size_t)(8 * i) * ldw);
    for (int kb = 0; kb < nk; ++kb) {
        const int k0 = 64 * kb;
#pragma unroll
        for (int i = 0; i < 8; ++i) { LAS float* d = scr + (8 * i + r8) * 33 + 4 * c4; d[0] = t[i].x; d[1] = t[i].y; d[2] = t[i].z; d[3] = t[i].w; }
        if (kb + 1 < nk) {
#pragma unroll
            for (int i = 0; i < 8; ++i) t[i] = *(const GAS f32x4*)(wp + (size_t)(k0 + 64 + 8 * i) * ldw); }
        asm volatile("s_waitcnt lgkmcnt(0)" ::: "memory");
        const int cch = lane & 7;
#pragma unroll
        for (int j = 0; j < 4; ++j) { const int n = (lane >> 3) + 8 * j; const LAS float* sp = scr + (8 * cch) * 33 + n; const float inv = invs[n];
            const int r = strip_row<MAP>(n0 + n);
            u32x2 o; o.x = pk4_i8(sp[0 * 33] * inv, sp[1 * 33] * inv, sp[2 * 33] * inv, sp[3 * 33] * inv); o.y = pk4_i8(sp[4 * 33] * inv, sp[5 * 33] * inv, sp[6 * 33] * inv, sp[7 * 33] * inv);
            *(GAS u32x2*)(WT + (size_t)(row_base + r) * K + k0 + 8 * cch) = o; }
        asm volatile("s_waitcnt lgkmcnt(0)" ::: "memory");
    }
}
struct StripDesc { const GAS float* W; int ldw; GAS unsigned char* WT; GAS float* CS; int row_base; int nb; int map; };
__device__ __forceinline__ int strip_row_rt(int map, int cidx) {
    if (map == 1) return wrow_in(cidx); if (map == 2) return wrow_gate(cidx); if (map == 3) return (cidx >> 7) * 256 + (cidx & 127); return cidx;
}
__device__ __forceinline__ void strip_load(const StripDesc& d, int wave, int lane, f32x4 (&t)[16]) {
    const GAS float* wp = d.W + (size_t)(128 * wave + (lane >> 3)) * d.ldw + 32 * d.nb + 4 * (lane & 7);
#pragma unroll
    for (int u = 0; u < 16; ++u) t[u] = *(const GAS f32x4*)(wp + (size_t)(8 * u) * d.ldw);
}
__device__ __forceinline__ void strip_finish(const StripDesc& d, const f32x4 (&t)[16], LAS float* scr, LAS float* red, int wave, int lane) {
    const int n0 = 32 * d.nb, r8 = lane >> 3, c4 = lane & 7;
    f32x4 m4 = {0.f, 0.f, 0.f, 0.f};
#pragma unroll
    for (int u = 0; u < 16; ++u) { m4.x = fmaxf(m4.x, fabsf(t[u].x)); m4.y = fmaxf(m4.y, fabsf(t[u].y)); m4.z = fmaxf(m4.z, fabsf(t[u].z)); m4.w = fmaxf(m4.w, fabsf(t[u].w)); }
#pragma unroll
    for (int o = 8; o < 64; o <<= 1) { m4.x = fmaxf(m4.x, __shfl_xor(m4.x, o)); m4.y = fmaxf(m4.y, __shfl_xor(m4.y, o)); m4.z = fmaxf(m4.z, __shfl_xor(m4.z, o)); m4.w = fmaxf(m4.w, __shfl_xor(m4.w, o)); }
    if (lane < 8) { LAS float* rp = red + wave * 32 + 4 * c4; rp[0] = m4.x; rp[1] = m4.y; rp[2] = m4.z; rp[3] = m4.w; }
    __syncthreads();
    LAS float* invs = scr + 64 * 33;
    if (lane < 32) { float m = red[lane];
#pragma unroll
        for (int w = 1; w < 8; ++w) m = fmaxf(m, red[w * 32 + lane]);
        m = fmaxf(m, 1e-20f); invs[lane] = 127.f / m;
        if (wave == 0) d.CS[d.row_base + strip_row_rt(d.map, n0 + lane)] = m * (1.f / 127.f); }
    asm volatile("s_waitcnt lgkmcnt(0)" ::: "memory");
#pragma unroll
    for (int kb = 0; kb < 2; ++kb) {
        const int k0 = 128 * wave + 64 * kb;
#pragma unroll
        for (int i = 0; i < 8; ++i) { LAS float* dd = scr + (8 * i + r8) * 33 + 4 * c4; const f32x4 v = t[8 * kb + i]; dd[0] = v.x; dd[1] = v.y; dd[2] = v.z; dd[3] = v.w; }
        asm volatile("s_waitcnt lgkmcnt(0)" ::: "memory");
        const int cch = lane & 7;
#pragma unroll
        for (int j = 0; j < 4; ++j) { const int n = (lane >> 3) + 8 * j; const LAS float* sp = scr + (8 * cch) * 33 + n; const float inv = invs[n];
            const int r = strip_row_rt(d.map, n0 + n);
            u32x2 o; o.x = pk4_i8(sp[0 * 33] * inv, sp[1 * 33] * inv, sp[2 * 33] * inv, sp[3 * 33] * inv); o.y = pk4_i8(sp[4 * 33] * inv, sp[5 * 33] * inv, sp[6 * 33] * inv, sp[7 * 33] * inv);
            *(GAS u32x2*)(d.WT + (size_t)(d.row_base + r) * 1024 + k0 + 8 * cch) = o; }
        asm volatile("s_waitcnt lgkmcnt(0)" ::: "memory");
    }
}
struct TrDesc { const GAS float* W; int ldw; int K; GAS void* WT; int row_base; int kb; int nb; int f8; };
__device__ __forceinline__ void tr_load(const TrDesc& d, int lane, f32x4 (&t)[8]) {
#pragma unroll
    for (int i = 0; i < 8; ++i) t[i] = *(const GAS f32x4*)(d.W + (size_t)(64 * d.kb + 8 * i + (lane >> 3)) * d.ldw + 32 * d.nb + 4 * (lane & 7));
}
__device__ __forceinline__ void tr_finish(const TrDesc& d, const f32x4 (&t)[8], LAS float* scr, int lane) {
    const int k0 = 64 * d.kb, n0 = 32 * d.nb;
#pragma unroll
    for (int i = 0; i < 8; ++i) { LAS float* dd = scr + (8 * i + (lane >> 3)) * 33 + 4 * (lane & 7); dd[0] = t[i].x; dd[1] = t[i].y; dd[2] = t[i].z; dd[3] = t[i].w; }
    asm volatile("s_waitcnt lgkmcnt(0)" ::: "memory");
    const int cch = lane & 7;
#pragma unroll
    for (int j = 0; j < 4; ++j) { const int n = (lane >> 3) + 8 * j; const LAS float* sp = scr + (8 * cch) * 33 + n; const int r = n0 + n;
        if (d.f8) { u32x2 o; o.x = pk4_fp8(sp[0 * 33] * 32.f, sp[1 * 33] * 32.f, sp[2 * 33] * 32.f, sp[3 * 33] * 32.f); o.y = pk4_fp8(sp[4 * 33] * 32.f, sp[5 * 33] * 32.f, sp[6 * 33] * 32.f, sp[7 * 33] * 32.f);
            *(GAS u32x2*)((GAS unsigned char*)d.WT + (size_t)(d.row_base + r) * d.K + k0 + 8 * cch) = o; }
        else { u32x4 o; o.x = pk2(sp[0 * 33], sp[1 * 33]); o.y = pk2(sp[2 * 33], sp[3 * 33]); o.z = pk2(sp[4 * 33], sp[5 * 33]); o.w = pk2(sp[6 * 33], sp[7 * 33]);
            *(GAS u32x4*)((GAS bf16_t*)d.WT + (size_t)(d.row_base + r) * d.K + k0 + 8 * cch) = o; } }
    asm volatile("s_waitcnt lgkmcnt(0)" ::: "memory");
}
__device__ __forceinline__ void ph_weights(const Ctx& c, GAS unsigned char* ws, int L) {
    const LAS Params& P = *c.p;
    LAS float* scr = (LAS float*)(c.lds + c.wave * 16384);
    LAS float* redb = (LAS float*)(c.lds + 8 * 16384);
    GAS unsigned char* wb = ws + OFF_W;
    GAS unsigned char* Win8 = wb + W_IN; GAS unsigned char* Wg = wb + W_GATE; GAS bf16_t* Wbr = (GAS bf16_t*)(wb + W_BR); GAS bf16_t* Wo = (GAS bf16_t*)(wb + W_O);
    GAS unsigned char* W13 = wb + W_13; GAS unsigned char* W2 = wb + W_2;
    const GAS float* win = gp(P.in[I_WIN]) + (size_t)L * 1024 * INW;
    const GAS float* wg = gp(P.in[I_WGATE]) + (size_t)L * 1024 * 4096;
    const GAS float* wbr = gp(P.in[I_WBR]) + (size_t)L * 4 * 512 * 1024;
    const GAS float* wo = gp(P.in[I_WO]) + (size_t)L * 1024 * 1024;
    const GAS float* w1 = gp(P.in[I_W1]) + (size_t)L * NE * 1024 * 512;
    const GAS float* w3 = gp(P.in[I_W3]) + (size_t)L * NE * 1024 * 512;
    const GAS float* w2 = gp(P.in[I_W2]) + (size_t)L * NE * 512 * 1024;
    GAS float* CS = (GAS float*)(ws + OFF_CS);
    constexpr int S_IN = 64, S_G = 128, S_E = 512, NSTRIP = 2 * S_IN + S_G + 2 * S_E;
    auto sdesc = [&](int it) -> StripDesc { int r = it; StripDesc d;
        if (r < S_IN) { d = StripDesc{win, INW, Win8, CS, 0, r, 1}; return d; } r -= S_IN;
        if (r < S_IN) { d = StripDesc{win + 2064, INW, Win8, CS, 2048, r, 0}; return d; } r -= S_IN;
        if (r < S_G) { d = StripDesc{wg, 4096, Wg, CS + 4096, 0, r, 2}; return d; } r -= S_G;
        if (r < S_E) { const int e = r >> 4, q = r & 15; d = StripDesc{w1 + (size_t)e * 1024 * 512, 512, W13, CS + 8192, e * 1024, q, 3}; return d; } r -= S_E;
        { const int e = r >> 4, q = r & 15; d = StripDesc{w3 + (size_t)e * 1024 * 512, 512, W13, CS + 8192, e * 1024 + 128, q, 3}; return d; } };
    __syncthreads();
    { f32x4 ta[16], tb[16]; StripDesc da, db; int it = c.bid, par = 0;
      if (it < NSTRIP) { da = sdesc(it); strip_load(da, c.wave, c.lane, ta); }
      while (it < NSTRIP) {
          const int n1 = it + c.nblk; if (n1 < NSTRIP) { db = sdesc(n1); strip_load(db, c.wave, c.lane, tb); }
          strip_finish(da, ta, scr, redb + (par & 1) * 256, c.wave, c.lane); ++par;
          if (n1 >= NSTRIP) break;
          const int n2 = n1 + c.nblk; if (n2 < NSTRIP) { da = sdesc(n2); strip_load(da, c.wave, c.lane, ta); }
          strip_finish(db, tb, scr, redb + (par & 1) * 256, c.wave, c.lane); ++par;
          it = n2; } }
    constexpr int N_BR = 1024, N_O = 512, N_W2 = 8192;
    constexpr int TOTAL = N_BR + N_O + N_W2;
    auto tdesc = [&](int it) -> TrDesc { int r = it; TrDesc d;
        if (r < N_BR) { const int n = r >> 8, q = r & 255; d = TrDesc{wbr + (size_t)n * 512 * 1024, 1024, 512, (GAS void*)Wbr, n * 1024, q / 32, q % 32, 0}; return d; } r -= N_BR;
        if (r < N_O) { d = TrDesc{wo, 1024, 1024, (GAS void*)Wo, 0, r / 32, r % 32, 0}; return d; } r -= N_O;
        { const int e = r >> 8, q = r & 255; d = TrDesc{w2 + (size_t)e * 512 * 1024, 1024, 512, (GAS void*)W2, e * 1024, q / 32, q % 32, 1}; return d; } };
    { f32x4 ta[8], tb[8]; TrDesc da, db; int it = c.gw;
      if (it < TOTAL) { da = tdesc(it); tr_load(da, c.lane, ta); }
      while (it < TOTAL) {
          const int n1 = it + c.ngw; if (n1 < TOTAL) { db = tdesc(n1); tr_load(db, c.lane, tb); }
          tr_finish(da, ta, scr, c.lane);
          if (n1 >= TOTAL) break;
          const int n2 = n1 + c.ngw; if (n2 < TOTAL) { da = tdesc(n2); tr_load(da, c.lane, ta); }
          tr_finish(db, tb, scr, c.lane);
          it = n2; } }
}

__device__ __forceinline__ const GAS float* mod_row(const GAS unsigned char* ws, int L, int row) { const int r = (row < NL) ? (row >> 13) : 4; return (const GAS float*)(ws + OFF_MOD) + ((size_t)L * 5 + r) * 6144; }
__device__ __forceinline__ void load_xr(GAS unsigned char* ws, int row, int lane, u32x2 (&r)[4]) {
    const GAS bf16_t* xr = (const GAS bf16_t*)(ws + OFF_XR) + (size_t)row * 1024;
#pragma unroll
    for (int j = 0; j < 4; ++j) r[j] = *(const GAS u32x2*)(xr + 4 * lane + 256 * j);
}
__device__ __forceinline__ f32x4 unpack4(u32x2 w) { return (f32x4){bflo(w.x), bfhi(w.x), bflo(w.y), bfhi(w.y)}; }

__device__ __forceinline__ void norm_mod(f32x4 (&v)[4], const GAS float* g, const GAS float* shift, const GAS float* scale, int lane) {
    float ss = 0.f;
#pragma unroll
    for (int j = 0; j < 4; ++j) ss += (v[j].x * v[j].x + v[j].y * v[j].y) + (v[j].z * v[j].z + v[j].w * v[j].w);
    const float rs = rsqrtf(wave_sum(ss) * (1.f / 1024.f) + EPS);
#pragma unroll
    for (int j = 0; j < 4; ++j) { const int idx = 4 * lane + 256 * j; const f32x4 gg = *(const GAS f32x4*)(g + idx);
        f32x4 y = v[j] * rs * gg;
        if (shift) { const f32x4 sh = *(const GAS f32x4*)(shift + idx), sc = *(const GAS f32x4*)(scale + idx); y = y * (sc + 1.f) + sh; }
        v[j] = y; }
}
__device__ __forceinline__ void store_row_bf16(GAS bf16_t* dst, const f32x4 (&v)[4], int lane) {
#pragma unroll
    for (int j = 0; j < 4; ++j) { u32x2 w; w.x = pk2(v[j].x, v[j].y); w.y = pk2(v[j].z, v[j].w); *(GAS u32x2*)(dst + 4 * lane + 256 * j) = w; }
}
__device__ __forceinline__ void store_row_i8(GAS unsigned char* dst, GAS float* hs, const f32x4 (&v)[4], int lane) {
    float m = 0.f;
#pragma unroll
    for (int j = 0; j < 4; ++j) m = fmaxf(fmaxf(m, fmaxf(fabsf(v[j].x), fabsf(v[j].y))), fmaxf(fabsf(v[j].z), fabsf(v[j].w)));
#pragma unroll
    for (int o = 1; o < 64; o <<= 1) m = fmaxf(m, __shfl_xor(m, o));
    m = fmaxf(m, 1e-20f); const float inv = 127.f / m;
#pragma unroll
    for (int j = 0; j < 4; ++j) *(GAS unsigned*)(dst + 4 * lane + 256 * j) = pk4_i8(v[j].x * inv, v[j].y * inv, v[j].z * inv, v[j].w * inv);
    if (lane == 0) hs[0] = m * (1.f / 127.f);
}
__device__ __forceinline__ void store_row_fp8(GAS unsigned char* dst, const f32x4 (&v)[4], int lane) {
#pragma unroll
    for (int j = 0; j < 4; ++j) *(GAS unsigned*)(dst + 4 * lane + 256 * j) = pk4_fp8(v[j].x, v[j].y, v[j].z, v[j].w);
}
__device__ __forceinline__ void load_wdt(const Ctx& c, int L) {
    const GAS float* win = gp(c.p->in[I_WIN]) + (size_t)L * 1024 * INW + 2048;
    LAS float* wl = (LAS float*)c.lds;
    for (int i = c.tid; i < 1024 * 16; i += 512) { const int k = i >> 4, j = i & 15; const int jj = k >> 8, ln = (k & 255) >> 2, e = k & 3, q = j >> 2, r = j & 3;
        wl[((jj * 4 + e) * 4 + q) * 256 + ln * 4 + r] = win[(size_t)k * INW + j]; }
    __syncthreads();
}
__device__ __forceinline__ void dt_row(const Ctx& c, const f32x4 (&h)[4], GAS float* dtout) {
    const LAS float* wl = (const LAS float*)c.lds;
    f32x4 a[4];
#pragma unroll
    for (int q = 0; q < 4; ++q) a[q] = (f32x4){0.f, 0.f, 0.f, 0.f};
#pragma unroll
    for (int jj = 0; jj < 4; ++jj)
#pragma unroll
        for (int e = 0; e < 4; ++e) { const float hv = h[jj][e];
#pragma unroll
            for (int q = 0; q < 4; ++q) { const f32x4 w = *(const LAS f32x4*)(wl + ((jj * 4 + e) * 4 + q) * 256 + c.lane * 4); a[q] = a[q] + w * hv; }
            asm volatile("" ::: "memory"); }
    float vv[16];
#pragma unroll
    for (int q = 0; q < 4; ++q)
#pragma unroll
        for (int r = 0; r < 4; ++r) vv[q * 4 + r] = a[q][r];
    const float mine = wave_reduce_scatter16(vv, c.lane);
    if ((c.lane & 3) == 0) dtout[c.lane >> 2] = mine;
}
__device__ __forceinline__ void ph_norm1_init(const Ctx& c, GAS unsigned char* ws) {
    const LAS Params& P = *c.p;
    load_wdt(c, 0);
    GAS bf16_t* H = (GAS bf16_t*)(ws + OFF_H); GAS float* DT = (GAS float*)(ws + OFF_DT);
    f32x4 nx[4];
    { const int row = c.gw; if (row < NT) { const GAS float* src = (row < NL) ? (gp(P.in[I_X]) + (size_t)row * 1024) : (gp(P.in[I_CTX]) + (size_t)(row - NL) * 1024);
#pragma unroll
        for (int j = 0; j < 4; ++j) nx[j] = *(const GAS f32x4*)(src + 4 * c.lane + 256 * j); } }
    for (int row = c.gw; row < NT; row += c.ngw) {
        f32x4 v[4];
#pragma unroll
        for (int j = 0; j < 4; ++j) v[j] = nx[j];
        { const int nr = row + c.ngw; if (nr < NT) { const GAS float* src = (nr < NL) ? (gp(P.in[I_X]) + (size_t)nr * 1024) : (gp(P.in[I_CTX]) + (size_t)(nr - NL) * 1024);
#pragma unroll
            for (int j = 0; j < 4; ++j) nx[j] = *(const GAS f32x4*)(src + 4 * c.lane + 256 * j); } }
        const GAS float* md = mod_row(ws, 0, row);
        norm_mod(v, gp(P.in[I_N1W]), md, md + 1024, c.lane);
        store_row_i8(ws + OFF_H8 + (size_t)row * 1024, (GAS float*)(ws + OFF_HS) + row, v, c.lane);
        dt_row(c, v, DT + (size_t)row * 16);
    }
}

__device__ __forceinline__ void ph_norm2_router(const Ctx& c, GAS unsigned char* ws, int L, int nrows_lat_ctx) {
    const LAS Params& P = *c.p;
    LAS float* wl = (LAS float*)c.lds;
    LAS unsigned* hist = (LAS unsigned*)(c.lds + 131072);
    const GAS float* wr = gp(P.in[I_WROUTER]);
    for (int i = c.tid; i < 1024 * 32; i += 512) { const int k = i >> 5, j = i & 31; const int jj = k >> 8, ln = (k & 255) >> 2, e = k & 3, q = j >> 2, r = j & 3;
        wl[((jj * 4 + e) * 8 + q) * 256 + ln * 4 + r] = wr[i]; }
    if (c.tid < 32) hist[c.tid] = 0u;
    __syncthreads();
    GAS bf16_t* H = (GAS bf16_t*)(ws + OFF_H);
    GAS int* tok_e = (GAS int*)(ws + OFF_TOKE); GAS float* tok_w = (GAS float*)(ws + OFF_TOKW); GAS int* rowtok = (GAS int*)(ws + OFF_ROWTOK);
    for (int i = c.bid * 512 + c.tid; i < MAXROWS; i += c.nblk * 512) rowtok[i] = NT;
    if (c.gw == 0) { for (int j = 0; j < 4; ++j) *(GAS unsigned*)(ws + OFF_H8 + (size_t)NT * 1024 + 4 * c.lane + 256 * j) = 0u; if (c.lane == 0) ((GAS float*)(ws + OFF_HS))[NT] = 0.f; }
    const GAS float* rbias = gp(P.in[I_RBIAS]);
    auto prep_row = [&](int row, const u32x2 (&nx)[4], f32x4 (&v)[4]) {
#pragma unroll
        for (int j = 0; j < 4; ++j) v[j] = unpack4(nx[j]);
        const GAS float* md = mod_row(ws, L, row);
        norm_mod(v, gp(P.in[I_N2W]) + L * 1024, md + 3 * 1024, md + 4 * 1024, c.lane);
        store_row_i8(ws + OFF_H8 + (size_t)row * 1024, (GAS float*)(ws + OFF_HS) + row, v, c.lane); };
    auto reduce_row = [&](const f32x4 (&a)[8]) -> float {
        float vv[32];
#pragma unroll
        for (int q = 0; q < 8; ++q)
#pragma unroll
            for (int r = 0; r < 4; ++r) vv[q * 4 + r] = a[q][r];
        return sigmoid_f(wave_reduce_scatter32(vv, c.lane)); };
    LAS float* wsc = (LAS float*)(c.lds + 131072 + 256) + c.wave * (8 * 36);
    auto finish_row = [&](int slot, int row) {
        float sc[32];
#pragma unroll
        for (int q = 0; q < 8; ++q) { const f32x4 t = *(const LAS f32x4*)(wsc + slot * 36 + 4 * q); sc[4 * q] = t.x; sc[4 * q + 1] = t.y; sc[4 * q + 2] = t.z; sc[4 * q + 3] = t.w; }
        float bestg = -1e30f; int bg = 0; float s0 = 0.f, s1 = 0.f, s2 = 0.f, s3 = 0.f, b0 = 0.f, b1 = 0.f, b2 = 0.f, b3 = 0.f;
#pragma unroll
        for (int g = 0; g < 8; ++g) {
            const float e0 = sc[4 * g] + rbias[4 * g], e1 = sc[4 * g + 1] + rbias[4 * g + 1], e2 = sc[4 * g + 2] + rbias[4 * g + 2], e3 = sc[4 * g + 3] + rbias[4 * g + 3];
            const float hi = fmaxf(e0, e1), lo = fminf(e0, e1), hi2 = fmaxf(e2, e3), lo2 = fminf(e2, e3);
            const float gs = fmaxf(hi, hi2) + fmaxf(fminf(hi, hi2), fmaxf(lo, lo2));
            if (gs > bestg) { bestg = gs; bg = g; s0 = e0; s1 = e1; s2 = e2; s3 = e3; b0 = sc[4 * g]; b1 = sc[4 * g + 1]; b2 = sc[4 * g + 2]; b3 = sc[4 * g + 3]; }
        }
        int i1 = 0; float m1 = s0; if (s1 > m1) { m1 = s1; i1 = 1; } if (s2 > m1) { m1 = s2; i1 = 2; } if (s3 > m1) { m1 = s3; i1 = 3; }
        int i2 = -1; float m2 = -1e30f;
        if (i1 != 0 && s0 > m2) { m2 = s0; i2 = 0; } if (i1 != 1 && s1 > m2) { m2 = s1; i2 = 1; } if (i1 != 2 && s2 > m2) { m2 = s2; i2 = 2; } if (i1 != 3 && s3 > m2) { m2 = s3; i2 = 3; }
        const float w1 = (i1 == 0) ? b0 : (i1 == 1) ? b1 : (i1 == 2) ? b2 : b3;
        const float w2 = (i2 == 0) ? b0 : (i2 == 1) ? b1 : (i2 == 2) ? b2 : b3;
        const float inv = 1.f / (w1 + w2);
        { const int ea = bg * 4 + i1, eb = bg * 4 + i2; tok_e[row * 2] = ea; tok_e[row * 2 + 1] = eb; tok_w[row * 2] = w1 * inv; tok_w[row * 2 + 1] = w2 * inv;
            __hip_atomic_fetch_add(&hist[ea], 1u, __ATOMIC_RELAXED, __HIP_MEMORY_SCOPE_WORKGROUP); __hip_atomic_fetch_add(&hist[eb], 1u, __ATOMIC_RELAXED, __HIP_MEMORY_SCOPE_WORKGROUP); } };
    const int st = c.ngw, nr = nrows_lat_ctx;
    u32x2 nxA[4] = {}, nxB[4] = {};
    if (c.gw < nr) load_xr(ws, c.gw, c.lane, nxA);
    if (c.gw + st < nr) load_xr(ws, c.gw + st, c.lane, nxB);
    for (int rb = c.gw; rb < nr; rb += 8 * st) {
#pragma unroll 1
        for (int pr = 0; pr < 4; ++pr) {
            const int row = rb + 2 * pr * st;
            if (row >= nr) break;
            const bool hasB = row + st < nr;
            f32x4 vA[4], vB[4];
            prep_row(row, nxA, vA);
            if (hasB) prep_row(row + st, nxB, vB); else {
#pragma unroll
                for (int j = 0; j < 4; ++j) vB[j] = (f32x4){0.f, 0.f, 0.f, 0.f}; }
            if (row + 2 * st < nr) load_xr(ws, row + 2 * st, c.lane, nxA);
            if (row + 3 * st < nr) load_xr(ws, row + 3 * st, c.lane, nxB);
            f32x4 aA[8], aB[8];
#pragma unroll
            for (int q = 0; q < 8; ++q) { aA[q] = (f32x4){0.f, 0.f, 0.f, 0.f}; aB[q] = (f32x4){0.f, 0.f, 0.f, 0.f}; }
#pragma unroll
            for (int jj = 0; jj < 4; ++jj)
#pragma unroll
                for (int e = 0; e < 4; ++e) { const float ha = vA[jj][e], hb = vB[jj][e];
#pragma unroll
                    for (int q = 0; q < 8; ++q) { const f32x4 w = *(const LAS f32x4*)(wl + ((jj * 4 + e) * 8 + q) * 256 + c.lane * 4); aA[q] = aA[q] + w * ha; aB[q] = aB[q] + w * hb; }
                    asm volatile("" ::: "memory"); }
            const float sgA = reduce_row(aA), sgB = reduce_row(aB);
            if ((c.lane & 1) == 0) { wsc[(2 * pr) * 36 + (c.lane >> 1)] = sgA; wsc[(2 * pr + 1) * 36 + (c.lane >> 1)] = sgB; }
        }
        asm volatile("s_waitcnt lgkmcnt(0)" ::: "memory");
        if (c.lane < 8) { const int row = rb + c.lane * st; if (row < nr) finish_row(c.lane, row); }
        asm volatile("s_waitcnt lgkmcnt(0)" ::: "memory");
    }
    __syncthreads();
    GAS unsigned* ctl = (GAS unsigned*)(ws + OFF_CTL);
    if (c.tid < 32) { const unsigned hv = hist[c.tid]; if (hv) __hip_atomic_fetch_add(&ctl[CW_CNT + L * 32 + c.tid], hv, __ATOMIC_RELAXED, __HIP_MEMORY_SCOPE_AGENT); }
}

__device__ __forceinline__ void ph_dispatch(const Ctx& c, GAS unsigned char* ws, int L, int nrows) {
    GAS unsigned* ctl = (GAS unsigned*)(ws + OFF_CTL);
    LAS int* pstart = (LAS int*)c.lds;
    LAS unsigned* lcnt = (LAS unsigned*)(c.lds + 256);
    LAS unsigned* lbase = (LAS unsigned*)(c.lds + 512);
    if (c.tid < 32) { lcnt[c.tid] = 0u; lbase[c.tid] = __hip_atomic_load(&ctl[CW_CNT + L * 32 + c.tid], __ATOMIC_RELAXED, __HIP_MEMORY_SCOPE_AGENT); }
    __syncthreads();
    if (c.tid == 0) { int s = 0; for (int e = 0; e < 32; ++e) { pstart[e] = s; s += ((int)lbase[e] + 255) & ~255; } pstart[32] = s; }
    __syncthreads();
    const GAS int* tok_e = (const GAS int*)(ws + OFF_TOKE); GAS int* pos_of = (GAS int*)(ws + OFF_POSOF); GAS int* rowtok = (GAS int*)(ws + OFF_ROWTOK); GAS int* tile_e = (GAS int*)(ws + OFF_TILEE);
    const int na = nrows * 2; const int per = (na + c.nblk - 1) / c.nblk; const int a0 = c.bid * per, a1 = min(na, a0 + per);
    int myr[2] = {0, 0}, mye[2] = {0, 0};
#pragma unroll
    for (int k = 0; k < 2; ++k) { const int a = a0 + c.tid + 512 * k; if (a < a1) { mye[k] = tok_e[a]; myr[k] = (int)__hip_atomic_fetch_add(&lcnt[mye[k]], 1u, __ATOMIC_RELAXED, __HIP_MEMORY_SCOPE_WORKGROUP); } }
    __syncthreads();
    if (c.tid < 32) { const unsigned n = lcnt[c.tid]; lbase[c.tid] = n ? __hip_atomic_fetch_add(&ctl[CW_CUR + L * 32 + c.tid], n, __ATOMIC_RELAXED, __HIP_MEMORY_SCOPE_AGENT) : 0u; }
    __syncthreads();
#pragma unroll
    for (int k = 0; k < 2; ++k) { const int a = a0 + c.tid + 512 * k; if (a < a1) { const int pos = pstart[mye[k]] + (int)lbase[mye[k]] + myr[k]; pos_of[a] = pos; rowtok[pos] = a >> 1; } }
    if (c.bid == 0) { const int ntile = pstart[32] >> 8;
        for (int t = c.tid; t < ntile; t += 512) { int e = 0; for (int q = 1; q < 32; ++q) if ((t << 8) >= pstart[q]) e = q; tile_e[t] = e; }
        if (c.tid == 0) ctl[CW_NT + L] = (unsigned)ntile;
        if (c.tid < 8) { GAS int* xi = tile_e + 512 + c.tid * 16; int acc = 0; xi[0] = 0;
            for (int q = 0; q < 4; ++q) { const int e = c.tid + 8 * q; xi[8 + q] = pstart[e] >> 8; acc += (pstart[e + 1] - pstart[e]) >> 8; xi[1 + q] = acc; } } }
}

__device__ __forceinline__ void ph_combine(const Ctx& c, GAS unsigned char* ws, int L, int nrows) {
    const LAS Params& P = *c.p;
    const bool last = (L == DEPTH - 1);
    if (!last) load_wdt(c, L + 1);
    GAS bf16_t* H = (GAS bf16_t*)(ws + OFF_H); GAS float* DT = (GAS float*)(ws + OFF_DT);
    const GAS bf16_t* YB = (const GAS bf16_t*)(ws + OFF_MYB); const GAS int* pos_of = (const GAS int*)(ws + OFF_POSOF); const GAS float* tok_w = (const GAS float*)(ws + OFF_TOKW);
    u32x2 nx[4], nya[4], nyb[4]; float nw0 = 0.f, nw1 = 0.f;
    int fp0 = 0, fp1 = 0; float fw0 = 0.f, fw1 = 0.f;
    auto fetch_info = [&](int row) { fp0 = pos_of[row * 2]; fp1 = pos_of[row * 2 + 1]; fw0 = tok_w[row * 2]; fw1 = tok_w[row * 2 + 1]; };
    auto fetch = [&](int row) { const int p0 = fp0, p1 = fp1; nw0 = fw0; nw1 = fw1; load_xr(ws, row, c.lane, nx);
#pragma unroll
        for (int j = 0; j < 4; ++j) { const int idx = 4 * c.lane + 256 * j; nya[j] = *(const GAS u32x2*)(YB + (size_t)p0 * 1024 + idx); nyb[j] = *(const GAS u32x2*)(YB + (size_t)p1 * 1024 + idx); } };
    if (c.gw < nrows) { fetch_info(c.gw); fetch(c.gw); if (c.gw + c.ngw < nrows) fetch_info(c.gw + c.ngw); }
    for (int row = c.gw; row < nrows; row += c.ngw) {
        const GAS float* md = mod_row(ws, L, row) + 5 * 1024;
        f32x4 v[4]; u32x2 ya[4], yb[4]; const float w0 = nw0, w1 = nw1;
#pragma unroll
        for (int j = 0; j < 4; ++j) { v[j] = unpack4(nx[j]); ya[j] = nya[j]; yb[j] = nyb[j]; }
        if (row + c.ngw < nrows) { fetch(row + c.ngw); if (row + 2 * c.ngw < nrows) fetch_info(row + 2 * c.ngw); }
#pragma unroll
        for (int j = 0; j < 4; ++j) { const int idx = 4 * c.lane + 256 * j; const f32x4 g = *(const GAS f32x4*)(md + idx);
            f32x4 f; f.x = w0 * bflo(ya[j].x) + w1 * bflo(yb[j].x); f.y = w0 * bfhi(ya[j].x) + w1 * bfhi(yb[j].x); f.z = w0 * bflo(ya[j].y) + w1 * bflo(yb[j].y); f.w = w0 * bfhi(ya[j].y) + w1 * bfhi(yb[j].y);
            v[j] = v[j] + g * f; }
        if (!last) {
            store_row_bf16((GAS bf16_t*)(ws + OFF_XR) + (size_t)row * 1024, v, c.lane);
            const GAS float* m2 = mod_row(ws, L + 1, row);
            norm_mod(v, gp(P.in[I_N1W]) + (L + 1) * 1024, m2, m2 + 1024, c.lane);
            store_row_i8(ws + OFF_H8 + (size_t)row * 1024, (GAS float*)(ws + OFF_HS) + row, v, c.lane);
            dt_row(c, v, DT + (size_t)row * 16);
        } else {
            norm_mod(v, gp(P.in[I_FNW]), nullptr, nullptr, c.lane);
            GAS float* xo = gp(P.out) + (size_t)row * 1024;
#pragma unroll
            for (int j = 0; j < 4; ++j) *(GAS f32x4*)(xo + 4 * c.lane + 256 * j) = v[j];
        }
    }
}

__device__ __forceinline__ void seq_of(int row, int& base, int& pos, int& len) {
    if (row < NL) { base = row & ~(SEQ - 1); pos = row & (SEQ - 1); len = SEQ; } else { const int r = row - NL; base = NL + (r & ~(LC - 1)); pos = r & (LC - 1); len = LC; }
}

__device__ __forceinline__ void ph_shortconv(const Ctx& c, GAS unsigned char* ws, int L, int nrows) {
    const GAS float* w = gp(c.p->in[I_SCW]) + (size_t)L * 3 * 512;
    const GAS bf16_t* PX = (const GAS bf16_t*)(ws + OFF_PX); GAS bf16_t* BR = (GAS bf16_t*)(ws + OFF_BR);
    for (int it = c.bid * 512 + c.tid; it < nrows * 64; it += c.nblk * 512) {
        const int row = it >> 6, c0 = (it & 63) * 8; int base, pos, len; seq_of(row, base, pos, len);
        const GAS bf16_t* pr = PX + (size_t)row * 2048;
        const u32x4 bgv = *(const GAS u32x4*)(pr + 512 + c0);
        float acc[8];
#pragma unroll
        for (int e = 0; e < 8; ++e) acc[e] = 0.f;
#pragma unroll
        for (int t = 0; t < 3; ++t) { const int pp = pos + t - 1; if (pp < 0 || pp >= len) continue;
            const GAS bf16_t* qr = PX + (size_t)(base + pp) * 2048; const u32x4 cg = *(const GAS u32x4*)(qr + 1024 + c0), xs = *(const GAS u32x4*)(qr + 1536 + c0);
#pragma unroll
            for (int h = 0; h < 4; ++h) { acc[2 * h] += w[t * 512 + c0 + 2 * h] * (bflo(cg[h]) * bflo(xs[h])); acc[2 * h + 1] += w[t * 512 + c0 + 2 * h + 1] * (bfhi(cg[h]) * bfhi(xs[h])); } }
        u32x4 o;
#pragma unroll
        for (int h = 0; h < 4; ++h) o[h] = pk2(bflo(bgv[h]) * acc[2 * h], bfhi(bgv[h]) * acc[2 * h + 1]);
        *(GAS u32x4*)(BR + (size_t)row * 2048 + 1536 + c0) = o;
    }
}

__device__ __forceinline__ void ph_chandft(const Ctx& c, GAS unsigned char* ws, int row_lo, int nrows) {
    const GAS f32x2* tw = (const GAS f32x2*)(ws + OFF_TW);
    LAS f32x2* t64 = (LAS f32x2*)c.lds;
    if (c.tid < 64) t64[c.tid] = tw[128 * c.tid];
    __syncthreads();
    const GAS bf16_t* PX = (const GAS bf16_t*)(ws + OFF_PX); GAS bf16_t* V = (GAS bf16_t*)(ws + OFF_V);
    for (int it = row_lo * 8 + c.gw; it < nrows * 8; it += c.ngw) {
        const int row = it >> 3, g = it & 7; const GAS bf16_t* u = PX + (size_t)row * 2048 + g * 64;
        float re = 0.f, im = 0.f;
#pragma unroll 8
        for (int cc = 0; cc < 64; cc += 2) { const unsigned uu = *(const GAS unsigned*)(u + cc);
            const f32x2 t0 = t64[(c.lane * cc) & 63], t1 = t64[(c.lane * (cc + 1)) & 63];
            const float u0 = bflo(uu), u1 = bfhi(uu);
            re += u0 * t0.x + u1 * t1.x; im -= u0 * t0.y + u1 * t1.y; }
        V[(size_t)row * 1024 + g * 128 + c.lane] = (bf16_t)f2bf(re * 0.125f); V[(size_t)row * 1024 + g * 128 + 64 + c.lane] = (bf16_t)f2bf(im * 0.125f);
    }
}
typedef float f32x16 __attribute__((ext_vector_type(16)));
typedef short s16x4 __attribute__((ext_vector_type(4)));
__device__ __forceinline__ s16x4 lds_tr16(LAS unsigned char* p) { return __builtin_amdgcn_ds_read_tr16_b64_v4i16((LAS s16x4*)p); }
__device__ __forceinline__ unsigned cvtpk(float lo, float hi) { return pg8::cvt_pk_bf16(lo, hi); }
__device__ __forceinline__ int crow16(int r, int hi) { return (r & 3) + 8 * (r >> 2) + 4 * hi; }
__device__ __forceinline__ void attn_mfma_unit(const Ctx& c, GAS unsigned char* ws, int L, int un) {
    const LAS Params& P = *c.p;
    const GAS bf16_t* PX = (const GAS bf16_t*)(ws + OFF_PX); GAS bf16_t* BR = (GAS bf16_t*)(ws + OFF_BR);
    const bool isctx = un >= 1024; int b, kvh, qb;
    if (!isctx) { b = un >> 8; kvh = (un >> 7) & 1; qb = un & 127; } else { const int u2 = un - 1024; b = u2 >> 3; kvh = (u2 >> 2) & 1; qb = u2 & 3; }
    const int lane = c.lane, r32 = lane & 31, hi = lane >> 5, w = c.wave, g = w >> 1, qs = w & 1, head = kvh * 4 + g;
    const int qi = qs * 32 + r32;
    const int qrow = (isctx ? (NL + b * LC) : (b * SEQ)) + qb * 64 + qi;
    bf16x8 qf[4];
#pragma unroll
    for (int s = 0; s < 4; ++s) qf[s] = *(const GAS bf16x8*)(PX + (size_t)qrow * 2048 + head * 64 + 16 * s + 8 * hi);
    int tlo = 0, nloc = 0;
    if (!isctx) { tlo = max(0, 2 - qb); const int thi = min(4, 129 - qb); nloc = thi - tlo + 1; }
    const int ntile = nloc + 4;
    LAS unsigned char* KB = c.lds; LAS unsigned char* VB = c.lds + 8192;
    const int koff = r32 * 128;
    const int voff = (4 * hi + ((lane & 15) >> 2)) * 128 + (16 * ((lane >> 4) & 1) + 4 * (lane & 3)) * 2;
    auto tile_row0 = [&](int ti) -> int { return (ti < nloc) ? (b * SEQ + qb * 64 - 128 + 64 * (tlo + ti)) : (NL + b * LC + 64 * (ti - nloc)); };
    const int dk = lane >> 3, dc = lane & 7;
    const int ksrc = (8 * w + dk) * 2048 + kvh * 64 + ((dc ^ dk) * 8) + 512, vsrc = (8 * w + dk) * 2048 + kvh * 64 + dc * 8 + 640;
    auto dma_tile = [&](int ti) { const GAS bf16_t* base = PX + (size_t)tile_row0(ti) * 2048; LAS unsigned char* d = c.lds + (ti & 3) * 16384 + w * 1024;
        __builtin_amdgcn_global_load_lds((const GAS unsigned*)(base + ksrc), (LAS unsigned*)d, 16, 0, 0);
        __builtin_amdgcn_global_load_lds((const GAS unsigned*)(base + vsrc), (LAS unsigned*)(d + 8192), 16, 0, 0); };
    __syncthreads();
    dma_tile(0); dma_tile(1); dma_tile(2);
    asm volatile("" :: "v"(qf[0]), "v"(qf[1]), "v"(qf[2]), "v"(qf[3]));
    f32x16 o0 = {}, o1 = {};
    float m_raw = -1e30f, lsum = 0.f;
    const float c2 = 0.125f * 1.4426950408889634f;
    for (int ti = 0; ti < ntile; ++ti) {
        const int buf = (ti & 3) * 16384;
        if (ti + 2 < ntile) asm volatile("s_waitcnt vmcnt(4)" ::: "memory"); else if (ti + 1 < ntile) asm volatile("s_waitcnt vmcnt(2)" ::: "memory"); else asm volatile("s_waitcnt vmcnt(0)" ::: "memory");
        __builtin_amdgcn_s_barrier(); asm volatile("" ::: "memory");
        if (ti + 3 < ntile) dma_tile(ti + 3);
        f32x16 p0 = {}, p1 = {};
        { bf16x8 kf0[4], kf1[4];
#pragma unroll
          for (int s = 0; s < 4; ++s) { const int ch = ((2 * s + hi) ^ (r32 & 7)) * 16; kf0[s] = *(const LAS bf16x8*)(KB + buf + koff + ch); kf1[s] = *(const LAS bf16x8*)(KB + buf + 4096 + koff + ch); }
          asm volatile("" : "+v"(kf0[0]), "+v"(kf0[1]), "+v"(kf0[2]), "+v"(kf0[3]), "+v"(kf1[0]), "+v"(kf1[1]), "+v"(kf1[2]), "+v"(kf1[3]));
#pragma unroll
          for (int s = 0; s < 4; ++s) { p0 = __builtin_amdgcn_mfma_f32_32x32x16_bf16(kf0[s], qf[s], p0, 0, 0, 0); p1 = __builtin_amdgcn_mfma_f32_32x32x16_bf16(kf1[s], qf[s], p1, 0, 0, 0); } }
        const int t = (ti < nloc) ? (tlo + ti) : 2;
        if (t == 0) {
#pragma unroll
            for (int r = 0; r < 16; ++r) { const int j = crow16(r, hi); if (j < qi) p0[r] = -1e30f; if (j + 32 < qi) p1[r] = -1e30f; }
        } else if (t == 4) {
#pragma unroll
            for (int r = 0; r < 16; ++r) { const int j = crow16(r, hi); if (j > qi) p0[r] = -1e30f; if (j + 32 > qi) p1[r] = -1e30f; }
        }
        float mx = p0[0];
#pragma unroll
        for (int r = 1; r < 16; ++r) mx = fmaxf(mx, p0[r]);
#pragma unroll
        for (int r = 0; r < 16; ++r) mx = fmaxf(mx, p1[r]);
        mx = fmaxf(mx, __shfl_xor(mx, 32));
        const float mn = fmaxf(m_raw, mx); const float alpha = __builtin_amdgcn_exp2f((m_raw - mn) * c2); m_raw = mn;
        const float nb = -mn * c2; float ps = 0.f;
#pragma unroll
        for (int r = 0; r < 16; ++r) { p0[r] = __builtin_amdgcn_exp2f(p0[r] * c2 + nb); p1[r] = __builtin_amdgcn_exp2f(p1[r] * c2 + nb); ps += p0[r] + p1[r]; }
        lsum = lsum * alpha + ps;
        if (!__all(alpha == 1.f)) {
#pragma unroll
            for (int r = 0; r < 16; ++r) { o0[r] *= alpha; o1[r] *= alpha; } }
        u32x4 pw[4];
#pragma unroll
        for (int q = 0; q < 4; ++q) { pw[0][q] = cvtpk(p0[2 * q], p0[2 * q + 1]); pw[1][q] = cvtpk(p0[8 + 2 * q], p0[8 + 2 * q + 1]); pw[2][q] = cvtpk(p1[2 * q], p1[2 * q + 1]); pw[3][q] = cvtpk(p1[8 + 2 * q], p1[8 + 2 * q + 1]); }
        {
          const unsigned va = (unsigned)(size_t)(VB + buf + voff);
          s16x4 a0[4], a1[4], b0[4], b1[4];
#pragma unroll
          for (int s = 0; s < 4; ++s)
              asm volatile("ds_read_b64_tr_b16 %0, %4 offset:%5\n\tds_read_b64_tr_b16 %1, %4 offset:%6\n\tds_read_b64_tr_b16 %2, %4 offset:%7\n\tds_read_b64_tr_b16 %3, %4 offset:%8"
                           : "=&v"(a0[s]), "=&v"(a1[s]), "=&v"(b0[s]), "=&v"(b1[s]) : "v"(va), "n"(s * 2048), "n"(s * 2048 + 1024), "n"(s * 2048 + 64), "n"(s * 2048 + 1088));
#pragma unroll
          for (int s = 0; s < 4; ++s) {
              if (s == 0) asm volatile("s_waitcnt lgkmcnt(12)" : "+v"(a0[0]), "+v"(a1[0]), "+v"(b0[0]), "+v"(b1[0]));
              else if (s == 1) asm volatile("s_waitcnt lgkmcnt(8)" : "+v"(a0[1]), "+v"(a1[1]), "+v"(b0[1]), "+v"(b1[1]));
              else if (s == 2) asm volatile("s_waitcnt lgkmcnt(4)" : "+v"(a0[2]), "+v"(a1[2]), "+v"(b0[2]), "+v"(b1[2]));
              else asm volatile("s_waitcnt lgkmcnt(0)" : "+v"(a0[3]), "+v"(a1[3]), "+v"(b0[3]), "+v"(b1[3]));
              const bf16x8 v0 = (bf16x8){a0[s][0], a0[s][1], a0[s][2], a0[s][3], a1[s][0], a1[s][1], a1[s][2], a1[s][3]}, v1 = (bf16x8){b0[s][0], b0[s][1], b0[s][2], b0[s][3], b1[s][0], b1[s][1], b1[s][2], b1[s][3]};
              const bf16x8 pb = __builtin_bit_cast(bf16x8, pw[s]);
              o0 = __builtin_amdgcn_mfma_f32_32x32x16_bf16(v0, pb, o0, 0, 0, 0);
              o1 = __builtin_amdgcn_mfma_f32_32x32x16_bf16(v1, pb, o1, 0, 0, 0); } }
    }
    { const float sk = gp(P.in[I_SINK])[L * 8 + head] * 8.f; const float mn = fmaxf(m_raw, sk); const float alpha = __builtin_amdgcn_exp2f((m_raw - mn) * c2);
      lsum = lsum * alpha; lsum += __shfl_xor(lsum, 32); lsum += __builtin_amdgcn_exp2f((sk - mn) * c2);
      const float inv = alpha / lsum;
      GAS bf16_t* op = BR + (size_t)qrow * 2048 + head * 64 + 4 * hi;
#pragma unroll
      for (int g4 = 0; g4 < 4; ++g4) { u32x2 w0, w1; w0.x = cvtpk(o0[4 * g4] * inv, o0[4 * g4 + 1] * inv); w0.y = cvtpk(o0[4 * g4 + 2] * inv, o0[4 * g4 + 3] * inv);
          w1.x = cvtpk(o1[4 * g4] * inv, o1[4 * g4 + 1] * inv); w1.y = cvtpk(o1[4 * g4 + 2] * inv, o1[4 * g4 + 3] * inv);
          *(GAS u32x2*)(op + 8 * g4) = w0; *(GAS u32x2*)(op + 32 + 8 * g4) = w1; } }
}

__device__ __forceinline__ void fft1_setup(const Ctx& c, GAS unsigned char* ws) {
    const GAS bf16_t* f128 = (const GAS bf16_t*)(ws + OFF_F128);
    __syncthreads();
    for (int i = c.tid; i < 2 * 128 * 16; i += 512) { const int tb = i >> 11, row = (i >> 4) & 127, ch = i & 15;
        const u32x4 v = *(const GAS u32x4*)(f128 + tb * 16384 + row * 128 + ch * 8);
        LAS unsigned char* d = c.lds + tb * 33792 + row * 264 + ch * 16;
        *(LAS u32x2*)d = (u32x2){v.x, v.y}; *(LAS u32x2*)(d + 8) = (u32x2){v.z, v.w}; }
    __syncthreads();
}
__device__ __forceinline__ bf16x8 f128_frag(const LAS unsigned char* tab, int k1, int ks, int hi) {
    const u32x2 a = *(const LAS u32x2*)(tab + k1 * 264 + (16 * ks + 4 * hi) * 2), b = *(const LAS u32x2*)(tab + k1 * 264 + (16 * ks + 8 + 4 * hi) * 2);
    return __builtin_bit_cast(bf16x8, (u32x4){a.x, a.y, b.x, b.y});
}
__device__ __forceinline__ void fft1_unit(const Ctx& c, GAS unsigned char* ws, int un) {
    const GAS bf16_t* PX = (const GAS bf16_t*)(ws + OFF_PX); GAS bf16_t* T = (GAS bf16_t*)(ws + OFF_T);
    const GAS bf16_t* f64 = (const GAS bf16_t*)(ws + OFF_F64); const GAS f32x2* tw = (const GAS f32x2*)(ws + OFF_TW);
    const int b = un >> 6, l2 = un & 63;
    const int w = c.wave, kb = w & 3, mb = w >> 2, lane = c.lane, r32 = lane & 31, hi = lane >> 5;
    const LAS unsigned char* COS = c.lds; const LAS unsigned char* SIN = c.lds + 33792;
    LAS f32x2* twl = (LAS f32x2*)(c.lds + 67584);
    __syncthreads();
    if (c.tid < 128) twl[c.tid] = tw[c.tid * l2];
    __syncthreads();
    bf16x8 fc[4], fs[4];
#pragma unroll
    for (int s = 0; s < 4; ++s) { fc[s] = *(const GAS bf16x8*)(f64 + (32 * mb + r32) * 64 + 16 * s + 8 * hi); fs[s] = *(const GAS bf16x8*)(f64 + 4096 + (32 * mb + r32) * 64 + 16 * s + 8 * hi); }
    const int k1l = 32 * kb + r32;
    LAS unsigned char* UT = c.lds + 69632;
    const int urow = 16 * w + (lane >> 3), uchk = (lane & 7) ^ (lane >> 3);
    const GAS bf16_t* usrc = PX + (size_t)(b * SEQ + 64 * urow + l2) * 2048 + uchk * 8;
    LAS unsigned char* udst = UT + w * 2048;
    __builtin_amdgcn_global_load_lds((const GAS unsigned*)usrc, (LAS unsigned*)udst, 16, 0, 0);
    __builtin_amdgcn_global_load_lds((const GAS unsigned*)(usrc + (size_t)512 * 2048), (LAS unsigned*)(udst + 1024), 16, 0, 0);
    asm volatile("s_waitcnt vmcnt(0)" ::: "memory");
    __syncthreads();
    for (int g = 0; g < 8; ++g) {
        const LAS unsigned char* UB = UT + (g & 1) * 16384;
        if (g + 1 < 8) { LAS unsigned char* un_ = udst + ((g + 1) & 1) * 16384;
            __builtin_amdgcn_global_load_lds((const GAS unsigned*)(usrc + (g + 1) * 64), (LAS unsigned*)un_, 16, 0, 0);
            __builtin_amdgcn_global_load_lds((const GAS unsigned*)(usrc + (size_t)512 * 2048 + (g + 1) * 64), (LAS unsigned*)(un_ + 1024), 16, 0, 0); }
        u32x4 vre[8], vq[8];
#pragma unroll
        for (int lb = 0; lb < 4; ++lb) {
            const int row = 32 * lb + r32;
            f32x16 xr = {}, xq = {};
#pragma unroll
            for (int s = 0; s < 4; ++s) { const bf16x8 u = *(const LAS bf16x8*)(UB + row * 128 + (((2 * s + hi) ^ (row & 7)) * 16)); xr = __builtin_amdgcn_mfma_f32_32x32x16_bf16(u, fc[s], xr, 0, 0, 0); xq = __builtin_amdgcn_mfma_f32_32x32x16_bf16(u, fs[s], xq, 0, 0, 0); }
#pragma unroll
            for (int q = 0; q < 4; ++q) { vre[2 * lb][q] = cvtpk(xr[2 * q], xr[2 * q + 1]); vre[2 * lb + 1][q] = cvtpk(xr[8 + 2 * q], xr[8 + 2 * q + 1]);
                vq[2 * lb][q] = cvtpk(xq[2 * q], xq[2 * q + 1]); vq[2 * lb + 1][q] = cvtpk(xq[8 + 2 * q], xq[8 + 2 * q + 1]); }
        }
        asm volatile("s_waitcnt vmcnt(0)" ::: "memory");
        __syncthreads();
        f32x16 a1 = {}, a2 = {}, pm = {};
#pragma unroll
        for (int ks = 0; ks < 8; ++ks) { const bf16x8 cf = f128_frag(COS, k1l, ks, hi), sf = f128_frag(SIN, k1l, ks, hi);
            const bf16x8 br = __builtin_bit_cast(bf16x8, vre[ks]), bq = __builtin_bit_cast(bf16x8, vq[ks]);
            a1 = __builtin_amdgcn_mfma_f32_32x32x16_bf16(cf, br, a1, 0, 0, 0); a2 = __builtin_amdgcn_mfma_f32_32x32x16_bf16(sf, bq, a2, 0, 0, 0);
            pm = __builtin_amdgcn_mfma_f32_32x32x16_bf16(sf, br, pm, 0, 0, 0); pm = __builtin_amdgcn_mfma_f32_32x32x16_bf16(cf, bq, pm, 0, 0, 0); }
        GAS bf16_t* tp = T + (size_t)(b * SEQ + l2) * 1024 + g * 128 + 32 * mb + r32;
#pragma unroll
        for (int r = 0; r < 16; ++r) { const int k1 = 32 * kb + crow16(r, hi); const f32x2 wv = twl[k1];
            const float tr = (a1[r] - a2[r]) * 0.011048543456039806f, pp = pm[r] * 0.011048543456039806f;
            GAS bf16_t* o = tp + (size_t)k1 * 64 * 1024;
            o[0] = (bf16_t)f2bf(tr * wv.x - pp * wv.y); o[64] = (bf16_t)f2bf(tr * wv.y + pp * wv.x); }
    }
}
__device__ __forceinline__ void fft2_unit(const Ctx& c, GAS unsigned char* ws, int un) {
    const GAS bf16_t* T = (const GAS bf16_t*)(ws + OFF_T); GAS bf16_t* BR = (GAS bf16_t*)(ws + OFF_BR); const GAS bf16_t* f64 = (const GAS bf16_t*)(ws + OFF_F64);
    const int b = un >> 7, k1 = un & 127;
    const int w = c.wave, kb = w & 1, lane = c.lane, r32 = lane & 31, hi = lane >> 5;
    LAS unsigned char* TT = c.lds;
    __syncthreads();
    for (int i = c.tid; i < 64 * 128; i += 512) { const int l2 = i >> 7, ch = i & 127; *(LAS u32x4*)(TT + l2 * 2048 + ch * 16) = *(const GAS u32x4*)(T + (size_t)(b * SEQ + k1 * 64 + l2) * 1024 + ch * 8); }
    bf16x8 fc[4], fs[4];
#pragma unroll
    for (int ks = 0; ks < 4; ++ks) { const GAS bf16_t* rp = f64 + (32 * kb + r32) * 64 + 16 * ks + 4 * hi;
        const u32x2 a = *(const GAS u32x2*)rp, bb = *(const GAS u32x2*)(rp + 8), sa = *(const GAS u32x2*)(rp + 4096), sb = *(const GAS u32x2*)(rp + 4096 + 8);
        fc[ks] = __builtin_bit_cast(bf16x8, (u32x4){a.x, a.y, bb.x, bb.y}); fs[ks] = __builtin_bit_cast(bf16x8, (u32x4){sa.x, sa.y, sb.x, sb.y}); }
    __syncthreads();
    for (int j = 0; j < 4; ++j) {
        const int cbk = (w >> 1) + 4 * j, g = cbk >> 1, mb = cbk & 1;
        f32x16 a1 = {}, a2 = {};
#pragma unroll
        for (int ks = 0; ks < 4; ++ks) {
            LAS unsigned char* pp = TT + (16 * ks + 4 * hi + ((lane & 15) >> 2)) * 2048 + (g * 128 + 32 * mb + 16 * ((lane >> 4) & 1) + 4 * (lane & 3)) * 2;
            const s16x4 x0 = lds_tr16(pp), x1 = lds_tr16(pp + 16384), y0 = lds_tr16(pp + 128), y1 = lds_tr16(pp + 128 + 16384);
            const bf16x8 br = (bf16x8){x0[0], x0[1], x0[2], x0[3], x1[0], x1[1], x1[2], x1[3]}, bp = (bf16x8){y0[0], y0[1], y0[2], y0[3], y1[0], y1[1], y1[2], y1[3]};
            a1 = __builtin_amdgcn_mfma_f32_32x32x16_bf16(fc[ks], br, a1, 0, 0, 0); a2 = __builtin_amdgcn_mfma_f32_32x32x16_bf16(fs[ks], bp, a2, 0, 0, 0);
        }
        GAS bf16_t* op = BR + (size_t)(b * SEQ + k1) * 2048 + 1024 + g * 64 + 32 * mb + r32;
#pragma unroll
        for (int r = 0; r < 16; ++r) { const int k2 = 32 * kb + crow16(r, hi); op[(size_t)k2 * 128 * 2048] = (bf16_t)f2bf((a1[r] - a2[r]) * 0.125f); }
    }
}

__device__ __forceinline__ void ctxfft_unit(const Ctx& c, GAS unsigned char* ws, int un) {
    const GAS bf16_t* V = (const GAS bf16_t*)(ws + OFF_V); GAS bf16_t* BR = (GAS bf16_t*)(ws + OFF_BR); const GAS bf16_t* f256 = (const GAS bf16_t*)(ws + OFF_F256);
    const int b = un >> 3, g = un & 7;
    const int kb = c.wave, lane = c.lane, r32 = lane & 31, hi = lane >> 5;
    LAS unsigned char* VT = c.lds;
    __syncthreads();
    for (int i = c.tid; i < 256 * 16; i += 512) { const int l = i >> 4, ch = i & 15; *(LAS u32x4*)(VT + l * 256 + ch * 16) = *(const GAS u32x4*)(V + (size_t)(NL + b * LC + l) * 1024 + g * 128 + ch * 8); }
    __syncthreads();
    const GAS bf16_t* crow = f256 + (size_t)(32 * kb + r32) * 256 + 4 * hi;
    for (int mb = 0; mb < 2; ++mb) {
        f32x16 a1 = {}, a2 = {};
#pragma unroll 4
        for (int ks = 0; ks < 16; ++ks) {
            const u32x2 ca = *(const GAS u32x2*)(crow + 16 * ks), cb2 = *(const GAS u32x2*)(crow + 16 * ks + 8), sa = *(const GAS u32x2*)(crow + 65536 + 16 * ks), sb = *(const GAS u32x2*)(crow + 65536 + 16 * ks + 8);
            const bf16x8 fc = __builtin_bit_cast(bf16x8, (u32x4){ca.x, ca.y, cb2.x, cb2.y}), fs = __builtin_bit_cast(bf16x8, (u32x4){sa.x, sa.y, sb.x, sb.y});
            LAS unsigned char* pp = VT + (16 * ks + 4 * hi + ((lane & 15) >> 2)) * 256 + (32 * mb + 16 * ((lane >> 4) & 1) + 4 * (lane & 3)) * 2;
            const s16x4 x0 = lds_tr16(pp), x1 = lds_tr16(pp + 2048), z0 = lds_tr16(pp + 128), z1 = lds_tr16(pp + 128 + 2048);
            const bf16x8 br = (bf16x8){x0[0], x0[1], x0[2], x0[3], x1[0], x1[1], x1[2], x1[3]}, bi = (bf16x8){z0[0], z0[1], z0[2], z0[3], z1[0], z1[1], z1[2], z1[3]};
            a1 = __builtin_amdgcn_mfma_f32_32x32x16_bf16(fc, br, a1, 0, 0, 0); a2 = __builtin_amdgcn_mfma_f32_32x32x16_bf16(fs, bi, a2, 0, 0, 0);
        }
        GAS bf16_t* op = BR + (size_t)(NL + b * LC) * 2048 + 1024 + g * 64 + 32 * mb + r32;
#pragma unroll
        for (int r = 0; r < 16; ++r) { const int k = 32 * kb + crow16(r, hi); op[(size_t)k * 2048] = (bf16_t)f2bf((a1[r] + a2[r]) * 0.0625f); }
    }
}

constexpr size_t OFF_S = OFF_V;
constexpr size_t OFF_DEC = OFF_TILEE + 4096;
__device__ __forceinline__ void chunk_rows(int b, int cidx, int& rbase, int& sbase, int& pos0, int& len) {
    if (cidx < 2) { sbase = NL + b * LC; pos0 = cidx * 128; len = LC; } else { sbase = b * SEQ; pos0 = (cidx - 2) * 128; len = SEQ; }
    rbase = sbase + pos0;
}
__device__ __forceinline__ void ssd_prep(const Ctx& c, GAS unsigned char* ws, int L, int h, int rbase) {
    const LAS Params& P = *c.p; const GAS float* DT = (const GAS float*)(ws + OFF_DT);
    LAS f32x4* ci = (LAS f32x4*)c.lds; LAS float* wf = (LAS float*)(c.lds + 2048); LAS float* wb = (LAS float*)(c.lds + 2560);
    LAS float* tmp = (LAS float*)(c.lds + 3072);
    __syncthreads();
    float dtf = 0.f, dtb = 0.f;
    if (c.tid < 128) {
        const float af = -__expf(gp(P.in[I_ALOG])[L * 16 + h]), ab = -__expf(gp(P.in[I_ALOG])[L * 16 + 8 + h]);
        dtf = softplus_f(DT[(size_t)(rbase + c.tid) * 16 + h] + gp(P.in[I_DTB])[L * 16 + h]);
        dtb = softplus_f(DT[(size_t)(rbase + c.tid) * 16 + 8 + h] + gp(P.in[I_DTB])[L * 16 + 8 + h]);
        tmp[c.tid] = af * dtf; tmp[128 + c.tid] = ab * dtb;
    }
    __syncthreads();
    if (c.tid < 128) {
        float cf = 0.f, rb = 0.f;
        for (int j = 0; j < 128; ++j) { const float a = tmp[j], bb = tmp[128 + j]; cf += (j <= c.tid) ? a : 0.f; rb += (j >= c.tid) ? bb : 0.f; }
        ci[c.tid] = (f32x4){cf, dtf, rb, dtb};
    }
    __syncthreads();
    if (c.tid < 128) { const f32x4 me = ci[c.tid]; const float cfe = ci[127].x, rb0 = ci[0].z; wf[c.tid] = me.y * __expf(cfe - me.x); wb[c.tid] = me.w * __expf(rb0 - me.z); }
    __syncthreads();
}
struct Raw3 { u32x4 x[3]; };
__device__ __forceinline__ Raw3 conv8_load(const GAS bf16_t* PX, int sbase, int pos, int len, int xc0) {
    Raw3 r;
#pragma unroll
    for (int t = 0; t < 3; ++t) { const int pp = pos + t - 1; const bool ok = (pp >= 0 && pp < len); const int pc = ok ? pp : pos;
        const u32x4 x = *(const GAS u32x4*)(PX + (size_t)(sbase + pc) * 2048 + 1280 + xc0); r.x[t] = ok ? x : (u32x4){0u, 0u, 0u, 0u}; }
    return r;
}
__device__ __forceinline__ void conv8_math(const Raw3& r, const GAS float* cw, const GAS float* cb, int xc0, float (&v)[8]) {
    { const f32x4 b0 = *(const GAS f32x4*)(cb + xc0), b1 = *(const GAS f32x4*)(cb + xc0 + 4); v[0] = b0.x; v[1] = b0.y; v[2] = b0.z; v[3] = b0.w; v[4] = b1.x; v[5] = b1.y; v[6] = b1.z; v[7] = b1.w; }
#pragma unroll
    for (int t = 0; t < 3; ++t) { const f32x4 w0 = *(const GAS f32x4*)(cw + t * 768 + xc0), w1 = *(const GAS f32x4*)(cw + t * 768 + xc0 + 4); const u32x4 x = r.x[t];
        v[0] += w0.x * bflo(x[0]); v[1] += w0.y * bfhi(x[0]); v[2] += w0.z * bflo(x[1]); v[3] += w0.w * bfhi(x[1]);
        v[4] += w1.x * bflo(x[2]); v[5] += w1.y * bfhi(x[2]); v[6] += w1.z * bflo(x[3]); v[7] += w1.w * bfhi(x[3]); }
#pragma unroll
    for (int e = 0; e < 8; ++e) v[e] = silu_f(v[e]);
}
__device__ __forceinline__ void conv8(const GAS bf16_t* PX, const GAS float* cw, const GAS float* cb, int sbase, int pos, int len, int xc0, float (&v)[8]) {
    const Raw3 r = conv8_load(PX, sbase, pos, len, xc0); conv8_math(r, cw, cb, xc0, v);
}
__device__ __forceinline__ u32x4 pack8(const float (&v)[8], float sc) { u32x4 o; o.x = pk2(v[0] * sc, v[1] * sc); o.y = pk2(v[2] * sc, v[3] * sc); o.z = pk2(v[4] * sc, v[5] * sc); o.w = pk2(v[6] * sc, v[7] * sc); return o; }
__device__ __forceinline__ bf16x8 tr_frag(LAS unsigned char* tile, int ks, int col32, int lane) {
    const int hi = lane >> 5;
    LAS unsigned char* pp = tile + (16 * ks + 4 * hi + ((lane & 15) >> 2)) * 128 + (col32 + 16 * ((lane >> 4) & 1) + 4 * (lane & 3)) * 2;
    const s16x4 a = lds_tr16(pp), b = lds_tr16(pp + 1024);
    return (bf16x8){a[0], a[1], a[2], a[3], b[0], b[1], b[2], b[3]};
}
__device__ __forceinline__ void ssd_state_unit(const Ctx& c, GAS unsigned char* ws, int L, int un) {
    const LAS Params& P = *c.p;
    const GAS bf16_t* PX = (const GAS bf16_t*)(ws + OFF_PX); GAS float* S = (GAS float*)(ws + OFF_S); GAS float* DEC = (GAS float*)(ws + OFF_DEC);
    const GAS float* cw = gp(P.in[I_CONVW]) + (size_t)L * 3 * 768; const GAS float* cb = gp(P.in[I_CONVB]) + (size_t)L * 768;
    const int h = un & 7, bc = un >> 3, b = bc / 66, cidx = bc % 66, grp = h >> 2;
    int rbase, sbase, pos0, len; chunk_rows(b, cidx, rbase, sbase, pos0, len);
    const bool doc = (h & 3) == 1;
    Raw3 rx[2], rb[2], rc[2];
#pragma unroll
    for (int k = 0; k < 2; ++k) { const int it = c.tid + 512 * k, q = it >> 3, g8 = it & 7;
        rx[k] = conv8_load(PX, sbase, pos0 + q, len, h * 64 + g8 * 8); rb[k] = conv8_load(PX, sbase, pos0 + q, len, 512 + grp * 64 + g8 * 8);
        if (doc) rc[k] = conv8_load(PX, sbase, pos0 + q, len, 640 + grp * 64 + g8 * 8); }
    ssd_prep(c, ws, L, h, rbase);
    LAS f32x4* ci = (LAS f32x4*)c.lds; const LAS float* wf = (const LAS float*)(c.lds + 2048); const LAS float* wb = (const LAS float*)(c.lds + 2560);
    LAS unsigned char* XF = c.lds + 4096; LAS unsigned char* XB = XF + 16384; LAS unsigned char* BT = XB + 16384;
    GAS bf16_t* XBC = (GAS bf16_t*)(ws + OFF_XBC);
    if (c.tid < 128) ((GAS f32x4*)(ws + OFF_CI))[(size_t)un * 128 + c.tid] = ci[c.tid];
#pragma unroll
    for (int k = 0; k < 2; ++k) { const int it = c.tid + 512 * k, q = it >> 3, g8 = it & 7; float v[8];
        conv8_math(rx[k], cw, cb, h * 64 + g8 * 8, v); *(LAS u32x4*)(XF + q * 128 + g8 * 16) = pack8(v, wf[q]); *(LAS u32x4*)(XB + q * 128 + g8 * 16) = pack8(v, wb[q]);
        *(GAS u32x4*)(XBC + (size_t)(rbase + q) * 768 + h * 64 + g8 * 8) = pack8(v, 1.f);
        conv8_math(rb[k], cw, cb, 512 + grp * 64 + g8 * 8, v); const u32x4 pk = pack8(v, 1.f); *(LAS u32x4*)(BT + q * 128 + g8 * 16) = pk;
        if ((h & 3) == 0) *(GAS u32x4*)(XBC + (size_t)(rbase + q) * 768 + 512 + grp * 64 + g8 * 8) = pk;
        if (doc) { conv8_math(rc[k], cw, cb, 640 + grp * 64 + g8 * 8, v); *(GAS u32x4*)(XBC + (size_t)(rbase + q) * 768 + 640 + grp * 64 + g8 * 8) = pack8(v, 1.f); } }
    __syncthreads();
    const int w = c.wave, dir = w >> 2, pt = (w >> 1) & 1, nt = w & 1, lane = c.lane, r32 = lane & 31, hi = lane >> 5;
    LAS unsigned char* XT = dir ? XB : XF;
    f32x16 acc = {};
#pragma unroll
    for (int ks = 0; ks < 8; ++ks) { const bf16x8 a = tr_frag(XT, ks, 32 * pt, lane), bb = tr_frag(BT, ks, 32 * nt, lane); acc = __builtin_amdgcn_mfma_f32_32x32x16_bf16(a, bb, acc, 0, 0, 0); }
    GAS float* so = S + ((((size_t)(b * 66 + cidx) * 8 + h) * 2 + dir) << 12);
#pragma unroll
    for (int r = 0; r < 16; ++r) so[(32 * pt + crow16(r, hi)) * 64 + 32 * nt + r32] = acc[r];
    if (c.tid == 0) { DEC[((b * 66 + cidx) * 8 + h) * 2] = __expf(ci[127].x); DEC[((b * 66 + cidx) * 8 + h) * 2 + 1] = __expf(ci[0].z); }
}
__device__ __forceinline__ void ssd_state_pair_unit(const Ctx& c, GAS unsigned char* ws, int L, int un) {
    const LAS Params& P = *c.p;
    const GAS bf16_t* PX = (const GAS bf16_t*)(ws + OFF_PX); GAS float* S = (GAS float*)(ws + OFF_S); GAS float* DEC = (GAS float*)(ws + OFF_DEC); const GAS float* DT = (const GAS float*)(ws + OFF_DT);
    const GAS float* cw = gp(P.in[I_CONVW]) + (size_t)L * 3 * 768; const GAS float* cb = gp(P.in[I_CONVB]) + (size_t)L * 768;
    const int hp = un & 3, bc = un >> 2, b = bc / 66, cidx = bc % 66, grp = hp >> 1, h0 = 2 * hp;
    int rbase, sbase, pos0, len; chunk_rows(b, cidx, rbase, sbase, pos0, len);
    const bool dobc = (hp & 1) == 0;
    LAS f32x4* ci = (LAS f32x4*)c.lds;
    LAS float* wf = (LAS float*)(c.lds + 4096); LAS float* wb = (LAS float*)(c.lds + 5120); LAS float* tmp = (LAS float*)(c.lds + 6144);
    LAS unsigned char* XF = c.lds + 8192; LAS unsigned char* XB = XF + 32768; LAS unsigned char* BT = XB + 32768;
    Raw3 rx[4], rb[2];
#pragma unroll
    for (int k = 0; k < 4; ++k) { const int it = c.tid + 512 * k, hh = it >> 10, q = (it >> 3) & 127, g8 = it & 7; rx[k] = conv8_load(PX, sbase, pos0 + q, len, (h0 + hh) * 64 + g8 * 8); }
#pragma unroll
    for (int k = 0; k < 2; ++k) { const int it = c.tid + 512 * k, q = it >> 3, g8 = it & 7; rb[k] = conv8_load(PX, sbase, pos0 + q, len, 512 + grp * 64 + g8 * 8); }
    __syncthreads();
    float dtf = 0.f, dtb = 0.f; const int hh_t = c.tid >> 7, i_t = c.tid & 127;
    if (c.tid < 256) { const int h = h0 + hh_t;
        const float af = -__expf(gp(P.in[I_ALOG])[L * 16 + h]), ab = -__expf(gp(P.in[I_ALOG])[L * 16 + 8 + h]);
        dtf = softplus_f(DT[(size_t)(rbase + i_t) * 16 + h] + gp(P.in[I_DTB])[L * 16 + h]);
        dtb = softplus_f(DT[(size_t)(rbase + i_t) * 16 + 8 + h] + gp(P.in[I_DTB])[L * 16 + 8 + h]);
        tmp[hh_t * 256 + i_t] = af * dtf; tmp[hh_t * 256 + 128 + i_t] = ab * dtb; }
    __syncthreads();
    if (c.tid < 256) { float cf = 0.f, rbv = 0.f; const LAS float* tp = tmp + hh_t * 256;
        for (int j = 0; j < 128; ++j) { const float a = tp[j], bb = tp[128 + j]; cf += (j <= i_t) ? a : 0.f; rbv += (j >= i_t) ? bb : 0.f; }
        ci[c.tid] = (f32x4){cf, dtf, rbv, dtb}; }
    __syncthreads();
    if (c.tid < 256) { const f32x4 me = ci[c.tid]; const float cfe = ci[hh_t * 128 + 127].x, rb0 = ci[hh_t * 128].z; wf[c.tid] = me.y * __expf(cfe - me.x); wb[c.tid] = me.w * __expf(rb0 - me.z);
        ((GAS f32x4*)(ws + OFF_CI))[((size_t)bc * 8 + h0 + hh_t) * 128 + i_t] = me; }
    __syncthreads();
    GAS bf16_t* XBC = (GAS bf16_t*)(ws + OFF_XBC);
#pragma unroll
    for (int k = 0; k < 4; ++k) { const int it = c.tid + 512 * k, hh = it >> 10, q = (it >> 3) & 127, g8 = it & 7; float v[8];
        conv8_math(rx[k], cw, cb, (h0 + hh) * 64 + g8 * 8, v);
        *(LAS u32x4*)(XF + hh * 16384 + q * 128 + g8 * 16) = pack8(v, wf[hh * 128 + q]); *(LAS u32x4*)(XB + hh * 16384 + q * 128 + g8 * 16) = pack8(v, wb[hh * 128 + q]);
        *(GAS u32x4*)(XBC + (size_t)(rbase + q) * 768 + (h0 + hh) * 64 + g8 * 8) = pack8(v, 1.f); }
#pragma unroll
    for (int k = 0; k < 2; ++k) { const int it = c.tid + 512 * k, q = it >> 3, g8 = it & 7; float v[8];
        conv8_math(rb[k], cw, cb, 512 + grp * 64 + g8 * 8, v); const u32x4 pk = pack8(v, 1.f); *(LAS u32x4*)(BT + q * 128 + g8 * 16) = pk;
        if (dobc) *(GAS u32x4*)(XBC + (size_t)(rbase + q) * 768 + 512 + grp * 64 + g8 * 8) = pk; }
    if (dobc) {
#pragma unroll
        for (int k = 0; k < 2; ++k) { const int it = c.tid + 512 * k, q = it >> 3, g8 = it & 7; float v[8];
            conv8(PX, cw, cb, sbase, pos0 + q, len, 640 + grp * 64 + g8 * 8, v); *(GAS u32x4*)(XBC + (size_t)(rbase + q) * 768 + 640 + grp * 64 + g8 * 8) = pack8(v, 1.f); } }
    __syncthreads();
    const int w = c.wave, hh = w >> 2, dir = (w >> 1) & 1, pt = w & 1, lane = c.lane, r32 = lane & 31, hi = lane >> 5;
    LAS unsigned char* XT = (dir ? XB : XF) + hh * 16384;
    GAS float* so = S + ((((size_t)bc * 8 + h0 + hh) * 2 + dir) << 12);
#pragma unroll
    for (int nt = 0; nt < 2; ++nt) {
        f32x16 acc = {};
#pragma unroll
        for (int ks = 0; ks < 8; ++ks) { const bf16x8 a = tr_frag(XT, ks, 32 * pt, lane), bb = tr_frag(BT, ks, 32 * nt, lane); acc = __builtin_amdgcn_mfma_f32_32x32x16_bf16(a, bb, acc, 0, 0, 0); }
#pragma unroll
        for (int r = 0; r < 16; ++r) so[(32 * pt + crow16(r, hi)) * 64 + 32 * nt + r32] = acc[r];
    }
    if (c.tid < 2) { const int h = h0 + c.tid; DEC[(bc * 8 + h) * 2] = __expf(ci[c.tid * 128 + 127].x); DEC[(bc * 8 + h) * 2 + 1] = __expf(ci[c.tid * 128].z); }
}
__device__ __forceinline__ void ph_ssd_scan(const Ctx& c, GAS unsigned char* ws) {
    GAS f32x2* S = (GAS f32x2*)(ws + OFF_S); const GAS float* DEC = (const GAS float*)(ws + OFF_DEC);
    for (int it = c.bid * 512 + c.tid; it < 4 * 8 * 2 * 2048; it += c.nblk * 512) {
        const int e = it & 2047, dir = (it >> 11) & 1, h = (it >> 12) & 7, b = it >> 15;
        f32x2 st = {0.f, 0.f};
        for (int k0 = 0; k0 < 66; k0 += 11) {
            f32x2 t[11]; float d[11]; size_t off[11];
#pragma unroll
            for (int u = 0; u < 11; ++u) { const int k = k0 + u; const int cidx = dir ? ((k < 2) ? (1 - k) : (67 - k)) : k;
                const size_t sidx = ((size_t)(b * 66 + cidx) * 8 + h) * 2 + dir; off[u] = (sidx << 11) + e; t[u] = S[off[u]]; d[u] = DEC[sidx]; }
#pragma unroll
            for (int u = 0; u < 11; ++u) { S[off[u]] = st; st = st * d[u] + t[u]; }
        }
    }
}
__device__ __forceinline__ void ssd_out_unit(const Ctx& c, GAS unsigned char* ws, int L, int un) {
    const LAS Params& P = *c.p;
    const GAS bf16_t* PX = (const GAS bf16_t*)(ws + OFF_PX); GAS bf16_t* BR = (GAS bf16_t*)(ws + OFF_BR); const GAS float* S = (const GAS float*)(ws + OFF_S);
    const GAS float* cw = gp(P.in[I_CONVW]) + (size_t)L * 3 * 768; const GAS float* cb = gp(P.in[I_CONVB]) + (size_t)L * 768;
    const int h = un & 7, bc = un >> 3, b = bc / 66, cidx = bc % 66, grp = h >> 2;
    int rbase, sbase, pos0, len; chunk_rows(b, cidx, rbase, sbase, pos0, len);
    LAS f32x4* ci = (LAS f32x4*)c.lds;
    LAS unsigned char* XT = c.lds + 4096; LAS unsigned char* BT = XT + 16384; LAS unsigned char* CT = BT + 16384;
    const GAS bf16_t* XBC = (const GAS bf16_t*)(ws + OFF_XBC);
    f32x4 sfr[2][4][2];
    { const int ph_ = c.wave >> 2, r32_ = c.lane & 31, hi_ = c.lane >> 5;
#pragma unroll
      for (int dir = 0; dir < 2; ++dir) { const GAS float* sp = S + ((((size_t)(b * 66 + cidx) * 8 + h) * 2 + dir) << 12) + (32 * ph_ + r32_) * 64;
#pragma unroll
          for (int s4 = 0; s4 < 4; ++s4) { sfr[dir][s4][0] = *(const GAS f32x4*)(sp + 16 * s4 + 8 * hi_); sfr[dir][s4][1] = *(const GAS f32x4*)(sp + 16 * s4 + 8 * hi_ + 4); } } }
    __syncthreads();
    { f32x4 civ; if (c.tid < 128) civ = ((const GAS f32x4*)(ws + OFF_CI))[(size_t)un * 128 + c.tid];
      u32x4 tx[2], tb[2], tc[2];
#pragma unroll
      for (int k = 0; k < 2; ++k) { const int it = c.tid + 512 * k, q = it >> 3, g8 = it & 7; const GAS bf16_t* rp = XBC + (size_t)(rbase + q) * 768 + g8 * 8;
          tx[k] = *(const GAS u32x4*)(rp + h * 64); tb[k] = *(const GAS u32x4*)(rp + 512 + grp * 64); tc[k] = *(const GAS u32x4*)(rp + 640 + grp * 64); }
      if (c.tid < 128) ci[c.tid] = civ;
#pragma unroll
      for (int k = 0; k < 2; ++k) { const int it = c.tid + 512 * k, q = it >> 3, g8 = it & 7;
          *(LAS u32x4*)(XT + q * 128 + g8 * 16) = tx[k]; *(LAS u32x4*)(BT + q * 128 + ((g8 ^ (q & 7)) * 16)) = tb[k]; *(LAS u32x4*)(CT + q * 128 + ((g8 ^ (q & 7)) * 16)) = tc[k]; } }
    __syncthreads();
    const int w = c.wave, ib = w & 3, ph = w >> 2, lane = c.lane, r32 = lane & 31, hi = lane >> 5;
    const int i = 32 * ib + r32;
    const f32x4 cii = ci[i];
    bf16x8 cfr[4];
#pragma unroll
    for (int s = 0; s < 4; ++s) cfr[s] = *(const LAS bf16x8*)(CT + i * 128 + (((2 * s + hi) ^ (i & 7)) * 16));
    u32x4 pw[8];
#pragma unroll
    for (int jb = 0; jb < 4; ++jb) {
        f32x16 x = {};
        const int jrow = 32 * jb + r32;
#pragma unroll
        for (int s = 0; s < 4; ++s) { const bf16x8 bf = *(const LAS bf16x8*)(BT + jrow * 128 + (((2 * s + hi) ^ (jrow & 7)) * 16)); x = __builtin_amdgcn_mfma_f32_32x32x16_bf16(bf, cfr[s], x, 0, 0, 0); }
        if (jb < ib) {
#pragma unroll
            for (int r = 0; r < 16; ++r) { const f32x4 cj = ci[32 * jb + crow16(r, hi)]; x[r] *= __expf(cii.x - cj.x) * cj.y; }
        } else if (jb > ib) {
#pragma unroll
            for (int r = 0; r < 16; ++r) { const f32x4 cj = ci[32 * jb + crow16(r, hi)]; x[r] *= __expf(cii.z - cj.z) * cj.w; }
        } else {
#pragma unroll
            for (int r = 0; r < 16; ++r) { const int j = 32 * jb + crow16(r, hi); const f32x4 cj = ci[j];
                float f;
                if (j < i) f = __expf(cii.x - cj.x) * cj.y; else if (j > i) f = __expf(cii.z - cj.z) * cj.w; else f = cj.y + cj.w;
                x[r] *= f; }
        }
#pragma unroll
        for (int q = 0; q < 4; ++q) { pw[2 * jb][q] = cvtpk(x[2 * q], x[2 * q + 1]); pw[2 * jb + 1][q] = cvtpk(x[8 + 2 * q], x[8 + 2 * q + 1]); }
    }
    f32x16 y = {};
#pragma unroll
    for (int ks = 0; ks < 8; ++ks) { const bf16x8 a = tr_frag(XT, ks, 32 * ph, lane); y = __builtin_amdgcn_mfma_f32_32x32x16_bf16(a, __builtin_bit_cast(bf16x8, pw[ks]), y, 0, 0, 0); }
#pragma unroll
    for (int dir = 0; dir < 2; ++dir) {
        f32x16 z = {};
#pragma unroll
        for (int s = 0; s < 4; ++s) { const f32x4 a0 = sfr[dir][s][0], a1 = sfr[dir][s][1];
            u32x4 aw; aw.x = cvtpk(a0.x, a0.y); aw.y = cvtpk(a0.z, a0.w); aw.z = cvtpk(a1.x, a1.y); aw.w = cvtpk(a1.z, a1.w);
            z = __builtin_amdgcn_mfma_f32_32x32x16_bf16(__builtin_bit_cast(bf16x8, aw), cfr[s], z, 0, 0, 0); }
        const float sc = __expf(dir ? cii.z : cii.x);
#pragma unroll
        for (int r = 0; r < 16; ++r) y[r] += z[r] * sc;
    }
    const float dsk = gp(P.in[I_SSMD])[L * 8 + h];
    GAS bf16_t* op = BR + (size_t)(rbase + i) * 2048 + 512 + h * 64 + 32 * ph + 4 * hi;
#pragma unroll
    for (int g4 = 0; g4 < 4; ++g4) { const u32x2 xv = *(const LAS u32x2*)(XT + i * 128 + (32 * ph + 8 * g4 + 4 * hi) * 2);
        u32x2 o; o.x = cvtpk(y[4 * g4] + dsk * bflo(xv.x), y[4 * g4 + 1] + dsk * bfhi(xv.x)); o.y = cvtpk(y[4 * g4 + 2] + dsk * bflo(xv.y), y[4 * g4 + 3] + dsk * bfhi(xv.y));
        *(GAS u32x2*)(op + 8 * g4) = o; }
}
__device__ __forceinline__ void ph_ssm_out2(const Ctx& c, GAS unsigned char* ws, int L, int nrows) {
    const LAS Params& P = *c.p;
    const GAS bf16_t* PX = (const GAS bf16_t*)(ws + OFF_PX); GAS bf16_t* BR = (GAS bf16_t*)(ws + OFF_BR); const GAS float* nw = gp(P.in[I_SSMNW]) + (size_t)L * 512;
    const int c0 = c.lane * 8;
    u32x4 nyv = {}, nzz = {};
    if (c.gw < nrows) { nyv = *(const GAS u32x4*)(BR + (size_t)c.gw * 2048 + 512 + c0); nzz = *(const GAS u32x4*)(PX + (size_t)c.gw * 2048 + 768 + c0); }
    for (int row = c.gw; row < nrows; row += c.ngw) {
        const u32x4 yv = nyv, zz = nzz;
        if (row + c.ngw < nrows) { nyv = *(const GAS u32x4*)(BR + (size_t)(row + c.ngw) * 2048 + 512 + c0); nzz = *(const GAS u32x4*)(PX + (size_t)(row + c.ngw) * 2048 + 768 + c0); }
        float y[8]; float ss = 0.f;
#pragma unroll
        for (int e = 0; e < 8; ++e) { const float f = (e & 1) ? bfhi(yv[e >> 1]) : bflo(yv[e >> 1]), z = (e & 1) ? bfhi(zz[e >> 1]) : bflo(zz[e >> 1]); y[e] = f * silu_f(z); ss += y[e] * y[e]; }
        const float rs = rsqrtf(wave_sum(ss) * (1.f / 512.f) + EPS);
        u32x4 o;
#pragma unroll
        for (int hh = 0; hh < 4; ++hh) o[hh] = pk2(y[2 * hh] * rs * nw[c0 + 2 * hh], y[2 * hh + 1] * rs * nw[c0 + 2 * hh + 1]);
        *(GAS u32x4*)(BR + (size_t)row * 2048 + 512 + c0) = o;
    }
}

constexpr size_t OFF_BAR = 16 * 1024;
#define XB_TMO      128
#define XB_XCNT(j)  (256  + 64 * (j))
#define XB_XSUB(j)  (1280 + 64 * (j))
#define XB_XGEN(j)  (2304 + 64 * (j))
#define XB_TOP      3328
#define XB_TOPGEN   3392
#define XCD_BAR_WORDS 3456
#define XB_SPIN_CAP (1u << 18)
__device__ __forceinline__ unsigned xb_ld(GAS unsigned* p)              { return __hip_atomic_load(p, __ATOMIC_RELAXED, __HIP_MEMORY_SCOPE_AGENT); }
__device__ __forceinline__ unsigned xb_add(GAS unsigned* p, unsigned v) { return __hip_atomic_fetch_add(p, v, __ATOMIC_RELAXED, __HIP_MEMORY_SCOPE_AGENT); }
__device__ __forceinline__ unsigned xb_xcc_id() { return (unsigned)__builtin_amdgcn_s_getreg((3 << 11) | 20) & 0xFu; }
#define XB_SPIN(cond, bar) do { unsigned _sp = 0; while (cond) { __builtin_amdgcn_s_sleep(1); \
    if ((++_sp & 255u) == 0u) { if (xb_ld(&(bar)[XB_TMO])) break; if (_sp > XB_SPIN_CAP) { xb_add(&(bar)[XB_TMO], 1u); break; } } } } while (0)
struct XcdBarrier { GAS unsigned* bar; unsigned x; volatile LAS unsigned* st; };
__device__ __forceinline__ XcdBarrier xcd_barrier_post(GAS unsigned* bar, volatile LAS unsigned* st) {
    XcdBarrier b; b.bar = bar; b.x = xb_xcc_id(); b.st = st;
    if (threadIdx.x == 0) st[2] = xb_add(&bar[XB_XCNT(b.x)], 1u);
    return b;
}
__device__ __forceinline__ void xcd_barrier_complete(GAS unsigned* bar, unsigned x, unsigned& nloc, unsigned& nx) {
    const unsigned G = gridDim.x * gridDim.y * gridDim.z;
    unsigned sum, cnt, mine, sp = 0u;
    for (;;) {
        sum = 0u; cnt = 0u; mine = 0u;
#pragma unroll
        for (unsigned j = 0; j < 16; ++j) { const unsigned c = xb_ld(&bar[XB_XCNT(j)]); sum += c; cnt += (c > 0u) ? 1u : 0u; mine = (j == x) ? c : mine; }
        if (sum == G) break;
        __builtin_amdgcn_s_sleep(1);
        if ((++sp & 255u) == 0u) { if (xb_ld(&bar[XB_TMO])) break; if (sp > XB_SPIN_CAP) { xb_add(&bar[XB_TMO], 1u); break; } }
    }
    nloc = mine > 0u ? mine : 1u; nx = cnt > 0u ? cnt : 1u;
}
__device__ __forceinline__ void xcd_barrier(const XcdBarrier& b) {
    asm volatile("s_waitcnt vmcnt(0)" ::: "memory");
    __syncthreads();
    if (threadIdx.x == 0) {
        GAS unsigned* bar = b.bar;
        __builtin_amdgcn_s_waitcnt(0);
        unsigned nloc = b.st[0], nx = b.st[1];
        if (nloc == 0u) { xcd_barrier_complete(bar, b.x, nloc, nx); b.st[0] = nloc; b.st[1] = nx; }
        const unsigned old = xb_add(&bar[XB_XSUB(b.x)], 1u);
        const unsigned gen = old / nloc;
        if (old + 1u == (gen + 1u) * nloc) {
            __builtin_amdgcn_fence(__ATOMIC_RELEASE, "agent");
            asm volatile("s_waitcnt vmcnt(0)" ::: "memory");
            const unsigned og = xb_add(&bar[XB_TOP], 1u);
            const unsigned tg = og / nx;
            if (og + 1u == (tg + 1u) * nx) xb_add(&bar[XB_TOPGEN], 1u);
            else XB_SPIN(xb_ld(&bar[XB_TOPGEN]) == tg, bar);
            __builtin_amdgcn_fence(__ATOMIC_ACQUIRE, "agent");
            xb_add(&bar[XB_XGEN(b.x)], 1u);
            asm volatile("s_waitcnt vmcnt(0)" ::: "memory");
        } else {
            XB_SPIN(xb_ld(&bar[XB_XGEN(b.x)]) == gen, bar);
            __builtin_amdgcn_fence(__ATOMIC_ACQUIRE, "agent");
            asm volatile("s_waitcnt vmcnt(0)" ::: "memory");
        }
    }
    __syncthreads();
}

__global__ void __launch_bounds__(512, 2) mega_fwd(Params P) {
    extern __shared__ __attribute__((aligned(16))) unsigned char lds_raw[];
    cg::grid_group grid = cg::this_grid();
    Ctx c; c.lds = (LAS unsigned char*)lds_raw; c.tid = threadIdx.x; c.lane = c.tid & 63; c.wave = __builtin_amdgcn_readfirstlane(c.tid >> 6);
    c.bid = blockIdx.x; c.nblk = gridDim.x; c.gw = c.bid * 8 + c.wave; c.ngw = c.nblk * 8; c.vbid = c.bid;
    { LAS Params* lp = (LAS Params*)(c.lds + LDS_PARAMS); if (c.tid < 29) ((LAS unsigned long long*)lp)[c.tid] = ((const GAS unsigned long long*)&P)[c.tid]; c.p = lp; }
    __syncthreads();
    GAS unsigned char* ws = gp(P.ws);
    GAS unsigned char* wb = ws + OFF_W;
    const GAS bf16_t* H = (const GAS bf16_t*)(ws + OFF_H);

#define SYNC() do { XcdBarrier xb_; xb_.bar = (GAS unsigned*)(ws + OFF_BAR); xb_.x = xb_xcc_id(); xb_.st = (volatile LAS unsigned*)(c.lds + LDS_PARAMS - 16); xcd_barrier(xb_); } while (0)
#define REFRESH() do { int t_ = threadIdx.x; asm volatile("" : "+v"(t_)); c.tid = t_; c.lane = t_ & 63; c.wave = __builtin_amdgcn_readfirstlane(t_ >> 6); { int b_ = blockIdx.x, n_ = gridDim.x; asm volatile("" : "+s"(b_), "+s"(n_)); c.bid = b_; c.nblk = n_; } c.gw = c.bid * 8 + c.wave; c.ngw = c.nblk * 8; c.vbid = (int)__builtin_amdgcn_readfirstlane((int)((volatile LAS unsigned*)(c.lds + LDS_PARAMS - 16))[3]); \
    asm volatile("" : "+s"(ws)); wb = ws + OFF_W; H = (const GAS bf16_t*)(ws + OFF_H); } while (0)

    volatile LAS unsigned* xst = (volatile LAS unsigned*)(c.lds + LDS_PARAMS - 16);
    if (c.tid < 4) xst[c.tid] = (c.tid == 3) ? (unsigned)blockIdx.x : 0u;
    ph_tables(c, ws); for (int rep = 0; rep < REP_W; ++rep) { ph_mod(c, ws); __syncthreads(); ph_weights(c, ws, 0); __syncthreads(); }
    grid.sync(); REFRESH();
    (void)xcd_barrier_post((GAS unsigned*)(ws + OFF_BAR), xst);
    for (int rep = 0; rep < REP_N; ++rep) { ph_norm1_init(c, ws); __syncthreads(); }
    SYNC();
    if (c.tid == 0) { GAS unsigned* bar = (GAS unsigned*)(ws + OFF_BAR); bool ok = (c.nblk % 8) == 0; const unsigned per = (unsigned)c.nblk / 8u;
        for (unsigned j = 0; j < 16; ++j) { const unsigned cn = xb_ld(&bar[XB_XCNT(j)]); ok = ok && (cn == ((j < 8) ? per : 0u)); }
        const unsigned x = xb_xcc_id(); xst[3] = (ok && x < 8u && xst[2] < per) ? (xst[2] * 8u + x) : (unsigned)blockIdx.x; }
    __syncthreads();
    REFRESH();
    for (int L = 0; L < DEPTH; ++L) {
        const bool need_ctx = (L + 1 < DEPTH);
        const int nrows = need_ctx ? NT : NL;
        const int nMfull = NT / 256, nMr = nrows / 256;
        const GAS float* MODL = (const GAS float*)(ws + OFF_MOD) + (size_t)L * 5 * 6144;
        { pg8::SchedDense S; S.o.init(need_ctx ? nMfull : NL / 256, 8, c.nblk, c.vbid); S.A = (const GAS char*)(ws + OFF_H8); S.Bt = (const GAS char*)(wb + W_IN) + (size_t)2048 * 1024; S.a_tile = (size_t)256 * 1024; S.b_tile = (size_t)256 * 1024; S.a_colgrp = 0; S.colgrp_shift = 0; S.cs = (const GAS float*)(ws + OFF_CS) + 2048; S.rs = (const GAS float*)(ws + OFF_HS);
          pg8::EpiStore E{(GAS bf16_t*)(ws + OFF_PX), 2048, 0, nullptr, 0, c.lds + 131072};
          for (int rep = 0; rep < REP_G; ++rep) pg8::gemm_phase<pg8::EpiStore, pg8::SchedDense, false, 2>(c.lds, 8, 1024, 1024, S, E); }
        SYNC(); REFRESH();
        for (int rep = 0; rep < REP_M; ++rep) {
        ph_shortconv(c, ws, L, nrows);
        if (need_ctx) ph_chandft(c, ws, NL, NT);
        fft1_setup(c, ws);
        for (int w = c.bid; w < 256; w += c.nblk) fft1_unit(c, ws, w); }
        SYNC(); REFRESH();
        { pg8::SchedDense S; S.o.init(nMfull, 8, c.nblk, c.vbid); S.A = (const GAS char*)(ws + OFF_H8); S.Bt = (const GAS char*)(wb + W_IN); S.a_tile = (size_t)256 * 1024; S.b_tile = (size_t)256 * 1024; S.a_colgrp = 0; S.colgrp_shift = 0; S.cs = (const GAS float*)(ws + OFF_CS); S.rs = (const GAS float*)(ws + OFF_HS);
          pg8::EpiStore E{(GAS bf16_t*)(ws + OFF_PX), 2048, 1, (const GAS f32x2*)(ws + OFF_ROPE), 0, c.lds + 131072};
          for (int rep = 0; rep < REP_G; ++rep) pg8::gemm_phase<pg8::EpiStore, pg8::SchedDense, false, 2>(c.lds, 8, 1024, 1024, S, E); }
        if (need_ctx) { const int nlate = (nMfull * 8) % c.nblk;
            for (int w = c.vbid - nlate; w >= 0 && w < 32; w += c.nblk) ctxfft_unit(c, ws, w); }
        SYNC(); REFRESH();
        { const int n_ssd = 4 * 66 * 4, n_att = need_ctx ? 1056 : 1024, n_fc = 512; const int total = n_ssd + n_att + n_fc;
#ifndef REP_DSEL
#define REP_DSEL 0
#endif
          const int xlo = (REP_DSEL == 1) ? 0 : (REP_DSEL == 2) ? n_att : (REP_DSEL == 3) ? n_att + n_ssd : 0;
          const int xn = (REP_D > 1) ? ((REP_DSEL == 1) ? n_att : (REP_DSEL == 2) ? n_ssd : (REP_DSEL == 3) ? n_fc : total) : 0;
          for (int w0 = c.bid; w0 < total + xn; w0 += c.nblk) { const int w = (w0 >= total) ? (xlo + (w0 - total)) : w0;
              __syncthreads();
              if (w < n_att) attn_mfma_unit(c, ws, L, w);
              else if (w < n_att + n_ssd) ssd_state_pair_unit(c, ws, L, w - n_att);
              else fft2_unit(c, ws, w - n_att - n_ssd);
          } }
        SYNC(); REFRESH();
        ph_ssd_scan(c, ws);
        SYNC(); REFRESH();
        for (int w0 = c.bid; w0 < 4 * 66 * 8 * REP_O; w0 += c.nblk) { const int w = (REP_O > 1) ? (w0 % (4 * 66 * 8)) : w0; if (!need_ctx && ((w >> 3) % 66) < 2) continue; __syncthreads(); ssd_out_unit(c, ws, L, w); }
        SYNC(); REFRESH();
        ph_ssm_out2(c, ws, L, nrows);
        SYNC(); REFRESH();
        { pg8::SchedDense S; S.o.init(nMr, 16, c.nblk, c.vbid); S.A = (const GAS char*)(ws + OFF_BR); S.Bt = (const GAS char*)(wb + W_BR); S.a_tile = (size_t)256 * 2048 * 2; S.b_tile = (size_t)256 * 512 * 2; S.a_colgrp = 512 * 2; S.colgrp_shift = 2; S.cs = nullptr; S.rs = nullptr;
          pg8::EpiStore E{(GAS bf16_t*)(ws + OFF_PG), 4096, 0, nullptr, 0, c.lds + 131072};
          for (int rep = 0; rep < REP_G; ++rep) pg8::gemm_phase<pg8::EpiStore, pg8::SchedDense, false>(c.lds, 8, 4096, 1024, S, E); }
        SYNC(); REFRESH();
        { pg8::SchedDense S; S.o.init(nMr, 16, c.nblk, c.vbid); S.A = (const GAS char*)(ws + OFF_H8); S.Bt = (const GAS char*)(wb + W_GATE); S.a_tile = (size_t)256 * 1024; S.b_tile = (size_t)256 * 1024; S.a_colgrp = 0; S.colgrp_shift = 0; S.cs = (const GAS float*)(ws + OFF_CS) + 4096; S.rs = (const GAS float*)(ws + OFF_HS);
          pg8::EpiGate E{(const GAS bf16_t*)(ws + OFF_PG), gp(c.p->in[I_BGATE]) + (size_t)L * 4096, (GAS bf16_t*)(ws + OFF_BR), c.lds + 131072};
          for (int rep = 0; rep < REP_G; ++rep) pg8::gemm_phase<pg8::EpiGate, pg8::SchedDense, false, 2>(c.lds, 8, 1024, 1024, S, E); }
        SYNC(); REFRESH();
        { pg8::SchedDense S; S.o.init(nMr, 4, c.nblk, c.vbid); S.A = (const GAS char*)(ws + OFF_BR); S.Bt = (const GAS char*)(wb + W_O); S.a_tile = (size_t)256 * 1024 * 2; S.b_tile = (size_t)256 * 1024 * 2; S.a_colgrp = 0; S.colgrp_shift = 0; S.cs = nullptr; S.rs = nullptr;
          pg8::EpiResid E{(GAS bf16_t*)(ws + OFF_XR), gp(c.p->in[I_X]), gp(c.p->in[I_CTX]), (L == 0) ? 1 : 0, MODL};
          pg8::gemm_phase<pg8::EpiResid, pg8::SchedDense, false>(c.lds, 16, 2048, 2048, S, E); }
        SYNC(); REFRESH();
        ph_norm2_router(c, ws, L, nrows);
        SYNC(); REFRESH();
        ph_dispatch(c, ws, L, nrows);
        SYNC(); REFRESH();
        { pg8::SchedMoe S; S.G = c.nblk; S.c = c.vbid; S.A = (const GAS char*)(ws + OFF_H8); S.Bt = (const GAS char*)(wb + W_13); S.rowtok = (const GAS int*)(ws + OFF_ROWTOK); S.xinfo = (const GAS int*)(ws + OFF_TILEE) + 512;
          S.a_tile = 0; S.e_stride = (size_t)1024 * 1024; S.b_tile = (size_t)256 * 1024; S.cs = (const GAS float*)(ws + OFF_CS) + 8192; S.rs = (const GAS float*)(ws + OFF_HS);
          pg8::EpiSwiglu E{ws + OFF_ACT};
          for (int rep = 0; rep < REP_G; ++rep) pg8::gemm_phase<pg8::EpiSwiglu, pg8::SchedMoe, true, 2>(c.lds, 8, 1024, 1024, S, E); }
        SYNC(); REFRESH();
        { pg8::SchedMoe S; S.G = c.nblk; S.c = c.vbid; S.A = (const GAS char*)(ws + OFF_ACT); S.Bt = (const GAS char*)(wb + W_2); S.rowtok = nullptr; S.xinfo = (const GAS int*)(ws + OFF_TILEE) + 512;
          S.a_tile = (size_t)256 * 512; S.e_stride = (size_t)1024 * 512; S.b_tile = (size_t)256 * 512; S.cs = nullptr; S.rs = nullptr;
          pg8::EpiStore E{(GAS bf16_t*)(ws + OFF_MYB), 1024, 0, nullptr, 0, c.lds + 131072};
          for (int rep = 0; rep < REP_G; ++rep) pg8::gemm_phase<pg8::EpiStore, pg8::SchedMoe, false, 1>(c.lds, 4, 512, 512, S, E, 0x7A7A7A7A, 0x7C7C7C7C); }
        SYNC(); REFRESH();
        ph_combine(c, ws, L, nrows);
        if (need_ctx) { for (int rep = 0; rep < REP_W; ++rep) { __syncthreads(); ph_weights(c, ws, L + 1); } SYNC(); REFRESH(); }
    }
}

extern "C" void kernel_launch(void* const* d_in, const int* in_sizes, int n_in, void* d_out, int out_size, void* d_ws, size_t ws_size, hipStream_t stream) {
    static int grid = 0;
    if (grid == 0) {
        if (n_in != 27 || out_size != NL * DM || ws_size < WS_END) { fprintf(stderr, "kernel_launch: unexpected problem (n_in %d out %d ws %zu)\n", n_in, out_size, ws_size); grid = -1; return; }
        int dev = 0, cus = 0, per_cu = 0;
        hipGetDevice(&dev); hipDeviceGetAttribute(&cus, hipDeviceAttributeMultiprocessorCount, dev);
        hipFuncSetAttribute((const void*)mega_fwd, hipFuncAttributeMaxDynamicSharedMemorySize, LDS_BYTES);
        hipOccupancyMaxActiveBlocksPerMultiprocessor(&per_cu, (const void*)mega_fwd, 512, LDS_BYTES);
        if (per_cu < 1) { fprintf(stderr, "kernel_launch: occupancy query says %d blocks per CU\n", per_cu); per_cu = 1; }
        grid = cus;
        fprintf(stderr, "kernel_launch: cus %d per_cu %d grid %d ws %zu\n", cus, per_cu, grid, ws_size);
    }
    if (grid < 0) return;
    Params p{};
    for (int i = 0; i < 27; ++i) p.in[i] = (const float*)d_in[i];
    p.out = (float*)d_out; p.ws = (unsigned char*)d_ws;
    void* args[] = {&p};
    hipError_t e = hipLaunchCooperativeKernel((const void*)mega_fwd, dim3(grid), dim3(512), args, LDS_BYTES, stream);
    if (e != hipSuccess) fprintf(stderr, "cooperative launch failed: %s (grid %d)\n", hipGetErrorString(e), grid);
}
```

```cpp
#include <hip/hip_runtime.h>
#include <hip/hip_cooperative_groups.h>
#include <cstdio>
#include <cstdint>
namespace cg = cooperative_groups;

#define LAS __attribute__((address_space(3)))
#define GAS __attribute__((address_space(1)))
typedef unsigned short bf16_t;
typedef short bf16x8 __attribute__((ext_vector_type(8)));
typedef float f32x4 __attribute__((ext_vector_type(4)));
typedef float f32x2 __attribute__((ext_vector_type(2)));
typedef unsigned u32x4 __attribute__((ext_vector_type(4)));
typedef unsigned u32x2 __attribute__((ext_vector_type(2)));

constexpr int DM = 1024, NB = 4, SEQ = 8192, LC = 256, DEPTH = 2;
constexpr int NL = NB * SEQ;
constexpr int NC = NB * LC;
constexpr int NT = NL + NC;
constexpr int INW = 4112;
constexpr int NE = 32;
constexpr int MAXT = 296;
constexpr int MAXROWS = MAXT * 256;
constexpr float EPS = 1e-6f;

constexpr size_t MiB = 1u << 20;
constexpr size_t OFF_CTL = 0;
constexpr size_t OFF_ROPE = 64 * 1024;
constexpr size_t OFF_TW = 128 * 1024;
constexpr size_t OFF_F64 = 80 * 1024;
constexpr size_t OFF_F128 = 192 * 1024;
constexpr size_t OFF_F256 = 512 * 1024;
constexpr size_t OFF_MOD = 256 * 1024;
constexpr size_t OFF_TOKE = 1 * MiB;
constexpr size_t OFF_TOKW = OFF_TOKE + 320 * 1024;
constexpr size_t OFF_POSOF = OFF_TOKW + 320 * 1024;
constexpr size_t OFF_ROWTOK = OFF_POSOF + 320 * 1024;
constexpr size_t OFF_TILEE = OFF_ROWTOK + 320 * 1024;
constexpr size_t OFF_DT = 3 * MiB;
constexpr size_t OFF_CS = 5 * MiB + 256 * 1024;
constexpr size_t OFF_HS = 5 * MiB + 512 * 1024;
constexpr size_t OFF_XC = 6 * MiB;
constexpr size_t OFF_XR = 128 * MiB;
constexpr size_t OFF_W = 10 * MiB;
constexpr size_t W_IN = 0, W_GATE = 8 * MiB, W_BR = 12 * MiB, W_O = 16 * MiB, W_13 = 18 * MiB, W_2 = 50 * MiB;
constexpr size_t OFF_H8 = OFF_W + 68 * MiB;
constexpr size_t OFF_H = 128 * MiB;
constexpr size_t OFF_W2B = 111 * MiB + 512 * 1024;
constexpr size_t OFF_BR = 198 * MiB;
constexpr size_t OFF_PX = 330 * MiB;
constexpr size_t OFF_T = 462 * MiB;
constexpr size_t OFF_V = 528 * MiB;
constexpr size_t OFF_PG = OFF_PX;
constexpr size_t OFF_YBK = 594 * MiB;
constexpr size_t OFF_MYB = OFF_PX;
constexpr size_t OFF_ACT = OFF_PX + 150 * MiB;
constexpr size_t OFF_XBC = 594 * MiB;
constexpr size_t OFF_CI = 644 * MiB;
constexpr size_t WS_END = 649 * MiB;
constexpr int CW_CNT = 0;
constexpr int CW_CUR = 64;
constexpr int CW_NT = 128;

#ifndef REP_D
#define REP_D 1
#endif
#ifndef REP_G
#define REP_G 1
#endif
#ifndef REP_M
#define REP_M 1
#endif
#ifndef REP_W
#define REP_W 1
#endif
#ifndef REP_O
#define REP_O 1
#endif
#ifndef REP_N
#define REP_N 1
#endif
constexpr int LDS_BYTES = 155648;
constexpr int LDS_PARAMS = 155648 - 256;

struct Params { const float* in[27]; float* out; unsigned char* ws; };
enum { I_X = 0, I_C, I_CTX, I_CCTX, I_N1W, I_N2W, I_WADA, I_BADA, I_WIN, I_SINK, I_CONVW, I_CONVB, I_DTB, I_ALOG, I_SSMD, I_SSMNW, I_SCW,
       I_WGATE, I_BGATE, I_WBR, I_WO, I_WROUTER, I_RBIAS, I_W1, I_W3, I_W2, I_FNW };

template <class T> __device__ __forceinline__ GAS T* gp(T* p) { return (GAS T*)p; }
__device__ __forceinline__ float bf2f(unsigned v) { return __uint_as_float(v << 16); }
__device__ __forceinline__ float bflo(unsigned u) { return __uint_as_float(u << 16); }
__device__ __forceinline__ float bfhi(unsigned u) { return __uint_as_float(u & 0xffff0000u); }
__device__ __forceinline__ unsigned f2bf(float f) { unsigned u = __float_as_uint(f); return (u + 0x7fffu + ((u >> 16) & 1u)) >> 16; }
__device__ __forceinline__ unsigned pk2(float lo, float hi) { return f2bf(lo) | (f2bf(hi) << 16); }
__device__ __forceinline__ float clamp_f8(float x) { return fminf(fmaxf(x, -440.f), 440.f); }
__device__ __forceinline__ unsigned pk4_fp8(float a, float b, float c, float d) { int w = 0; w = __builtin_amdgcn_cvt_pk_fp8_f32(a, b, w, false); w = __builtin_amdgcn_cvt_pk_fp8_f32(c, d, w, true); return (unsigned)w; }
__device__ __forceinline__ int q8(float x) { return (int)__builtin_rintf(x) & 255; }
__device__ __forceinline__ unsigned pk4_i8(float a, float b, float c, float d) { return (unsigned)(q8(a) | (q8(b) << 8) | (q8(c) << 16) | (q8(d) << 24)); }
__device__ __forceinline__ float silu_f(float x) { return x * __builtin_amdgcn_rcpf(1.f + __builtin_amdgcn_exp2f(-1.4426950408889634f * x)); }
__device__ __forceinline__ float sigmoid_f(float x) { return __builtin_amdgcn_rcpf(1.f + __builtin_amdgcn_exp2f(-1.4426950408889634f * x)); }
__device__ __forceinline__ float softplus_f(float x) { return fmaxf(x, 0.f) + log1pf(__expf(-fabsf(x))); }
__device__ __forceinline__ float wave_sum(float v) {
#pragma unroll
    for (int o = 1; o < 64; o <<= 1) v += __shfl_xor(v, o);
    return v;
}

template <int H, int BIT, int N> __device__ __forceinline__ void rs_step(float (&v)[N], int lane) {
    const bool up = (lane & BIT) != 0;
#pragma unroll
    for (int j = 0; j < H; ++j) { const float keep = up ? v[j + H] : v[j], send = up ? v[j] : v[j + H]; v[j] = keep + __shfl_xor(send, BIT); }
}
__device__ __forceinline__ float wave_reduce_scatter32(float (&v)[32], int lane) {
    rs_step<16, 32>(v, lane); rs_step<8, 16>(v, lane); rs_step<4, 8>(v, lane); rs_step<2, 4>(v, lane); rs_step<1, 2>(v, lane);
    return v[0] + __shfl_xor(v[0], 1);
}
__device__ __forceinline__ float wave_reduce_scatter16(float (&v)[16], int lane) {
    rs_step<8, 32>(v, lane); rs_step<4, 16>(v, lane); rs_step<2, 8>(v, lane); rs_step<1, 4>(v, lane);
    float r = v[0]; r += __shfl_xor(r, 2); r += __shfl_xor(r, 1); return r;
}

namespace pg8 {
constexpr int BM = 256, BK = 64, HALF = 128, HTB = HALF * BK * 2, STAGE_BYTES = 8 * HTB, NXCD = 8, WGM = 8;
__device__ __forceinline__ int lds_byte(int r, int c) { const int st = (r >> 4) * 2 + (c >> 5), rr = r & 15, cc = c & 31, ob = rr * 64 + cc * 2; return st * 1024 + (ob ^ (((ob >> 9) & 1) << 5)); }
__device__ __forceinline__ void stage_rc(int b, int& R, int& C) { const int st = b / 1024, sb = b % 1024, swz = sb ^ (((sb >> 9) & 1) << 5); R = (st >> 1) * 16 + swz / 64; C = (st & 1) * 32 + (swz % 64) / 2; }
__device__ __forceinline__ int perm32(int rho) { const int n = rho >> 4, i = rho & 15; return 8 * (i >> 2) + 4 * n + (i & 3); }
struct Unit { int pm, pn, aux; };

struct DenseOrder {
    int nM, nN, nwg, G, c;
    __device__ void init(int nM_, int nN_, int G_, int c_) { nM = nM_; nN = nN_; nwg = nM * nN; G = G_; c = c_; }
    __device__ bool next(int i, Unit& u) const {
        const long L = (long)i * G + c; if (L >= nwg) return false;
        int wgid = (int)L; { const int q = nwg / NXCD, r = nwg % NXCD, xcd = wgid % NXCD, off = wgid / NXCD; wgid = (xcd < r ? xcd * (q + 1) : r * (q + 1) + (xcd - r) * q) + off; }
        const int nig = WGM * nN, gid = wgid / nig, fm = gid * WGM, gsz = (nM - fm) < WGM ? (nM - fm) : WGM;
        u.pm = fm + ((wgid % nig) % gsz); u.pn = (wgid % nig) / gsz; u.aux = 0; return true;
    }
};

typedef int i32x8 __attribute__((ext_vector_type(8)));
typedef int i32x4 __attribute__((ext_vector_type(4)));
template <class Epi, class Sched, bool GATHER, int MODE = 0>
__device__ __forceinline__ void gemm_phase(LAS unsigned char* lds, const int nt, const int lda_b, const int ldb_b, const Sched& S, Epi& E, const int sc_w = 0x7F7F7F7F, const int sc_x = 0x7F7F7F7F) {
    constexpr bool FP8 = (MODE == 1), I8 = (MODE == 2);
    int tid_ = threadIdx.x; asm volatile("" : "+v"(tid_));
    const int tid = tid_, wid = __builtin_amdgcn_readfirstlane(tid >> 6), lane = tid & 63, wr = wid >> 2, wc = wid & 3, fr = lane & 15, fq = lane >> 4;
    unsigned vA0[2], vA1[2], vB[2], nA0[2], nA1[2]; int Rst[2], Cst[2];
#pragma unroll
    for (int i = 0; i < 2; ++i) { int R, C; stage_rc(tid * 16 + i * 8192, R, C); const int Rb = Epi::WCONT ? ((R >> 5) * 64 + perm32(R & 31)) : Epi::PERM ? ((R & ~31) + perm32(R & 31)) : R; Rst[i] = R; Cst[i] = C;
        vA0[i] = (unsigned)(R * lda_b + C * 2); vA1[i] = vA0[i] + (unsigned)(HALF * lda_b); vB[i] = (unsigned)(Rb * ldb_b + C * 2); nA0[i] = vA0[i]; nA1[i] = vA1[i]; }
    const size_t kstep = (size_t)(BK * 2);
    const size_t hstepB = (size_t)(Epi::WCONT ? 32 : HALF) * ldb_b;
    const unsigned ldsw = (unsigned)wid * 1024u;
    const int aoff = lds_byte(wr * 64 + fr, fq * 8), boff = lds_byte(wc * 32 + fr, fq * 8);
#define PG8_SA(b, h) (((b) * 2 + (h)) * HTB)
#define PG8_SB(b, h) ((4 + (b) * 2 + (h)) * HTB)
#define PG8_STAGE(bufoff, gbase, voff) do { _Pragma("unroll") for (int _i = 0; _i < 2; ++_i) \
        __builtin_amdgcn_global_load_lds((const GAS unsigned*)((const GAS char*)(gbase) + (voff)[_i]), (LAS unsigned*)(lds + (bufoff) + ldsw + _i * 8192), 16, 0, 0); } while (0)
#define PG8_LD32(addr) __builtin_bit_cast(i32x8, __builtin_shufflevector(*(const LAS bf16x8*)(addr), *(const LAS bf16x8*)((addr) + 1024), 0, 1, 2, 3, 4, 5, 6, 7, 8, 9, 10, 11, 12, 13, 14, 15))
#define PG8_LDA(dst, b, h) do { if constexpr (FP8) { _Pragma("unroll") for (int m = 0; m < 4; ++m) dst##8[m] = PG8_LD32(lds + PG8_SA(b, h) + aoff + m * 2048); } \
        else { _Pragma("unroll") for (int m = 0; m < 4; ++m) _Pragma("unroll") for (int k = 0; k < 2; ++k) dst[m][k] = *(const LAS bf16x8*)(lds + PG8_SA(b, h) + aoff + m * 2048 + k * 1024); } } while (0)
#define PG8_LDB(dst, b, h) do { if constexpr (FP8) { _Pragma("unroll") for (int n = 0; n < 2; ++n) dst##8[n] = PG8_LD32(lds + PG8_SB(b, h) + boff + n * 2048); } \
        else { _Pragma("unroll") for (int n = 0; n < 2; ++n) _Pragma("unroll") for (int k = 0; k < 2; ++k) dst[n][k] = *(const LAS bf16x8*)(lds + PG8_SB(b, h) + boff + n * 2048 + k * 1024); } } while (0)
#define PG8_MMA(ai, bj, At, Bt) do { __builtin_amdgcn_s_setprio(1); \
        if constexpr (FP8) { _Pragma("unroll") for (int m = 0; m < 4; ++m) _Pragma("unroll") for (int n = 0; n < 2; ++n) \
            asm volatile("v_mfma_scale_f32_16x16x128_f8f6f4 %0, %1, %2, %0, %3, %4 op_sel_hi:[0,0,0]" : "+v"(acc[ai][bj][m][n]) : "v"(Bt##8[n]), "v"(At##8[m]), "v"(vsw), "v"(vsx)); } \
        else if constexpr (I8) { _Pragma("unroll") for (int m = 0; m < 4; ++m) _Pragma("unroll") for (int n = 0; n < 2; ++n) _Pragma("unroll") for (int k = 0; k < 2; ++k) \
            acc[ai][bj][m][n] = __builtin_bit_cast(f32x4, __builtin_amdgcn_mfma_i32_16x16x64_i8(__builtin_bit_cast(i32x4, Bt[n][k]), __builtin_bit_cast(i32x4, At[m][k]), __builtin_bit_cast(i32x4, acc[ai][bj][m][n]), 0, 0, 0)); } \
        else { _Pragma("unroll") for (int m = 0; m < 4; ++m) _Pragma("unroll") for (int n = 0; n < 2; ++n) _Pragma("unroll") for (int k = 0; k < 2; ++k) \
            acc[ai][bj][m][n] = __builtin_amdgcn_mfma_f32_16x16x32_bf16(Bt[n][k], At[m][k], acc[ai][bj][m][n], 0, 0, 0); } \
        __builtin_amdgcn_s_setprio(0); } while (0)
#define PG8_WAIT_V(n) asm volatile("s_waitcnt vmcnt(" #n ")" ::: "memory")
#define PG8_WAIT_L(n) asm volatile("s_waitcnt lgkmcnt(" #n ")" ::: "memory")
#define PG8_BAR __builtin_amdgcn_s_barrier()
#define PG8_SCHED __builtin_amdgcn_sched_barrier(0)
    int vsw = sc_w, vsx = sc_x; asm volatile("" : "+v"(vsw), "+v"(vsx));
    Unit cur, nxt; int ui = 0;
    if (!S.next(0, cur)) return;
    if constexpr (GATHER) { const GAS int* ri = S.rowidx(cur);
#pragma unroll
        for (int i = 0; i < 2; ++i) { vA0[i] = (unsigned)(ri[Rst[i]] * lda_b + Cst[i] * 2); vA1[i] = (unsigned)(ri[HALF + Rst[i]] * lda_b + Cst[i] * 2); } }
    f32x4 acc[2][2][4][2];
#pragma unroll
    for (int a = 0; a < 2; ++a)
#pragma unroll
        for (int b = 0; b < 2; ++b)
#pragma unroll
            for (int m = 0; m < 4; ++m)
#pragma unroll
                for (int n = 0; n < 2; ++n) acc[a][b][m][n] = (f32x4){0.f, 0.f, 0.f, 0.f};
    bf16x8 At[4][2], B0[2][2], B1[2][2]; i32x8 At8[4], B08[2], B18[2];
    const GAS char* cA = S.abase(cur); const GAS char* cB = S.bbase(cur);
    PG8_STAGE(PG8_SB(0, 0), cB, vB); PG8_STAGE(PG8_SB(0, 1), cB + hstepB, vB); PG8_STAGE(PG8_SA(0, 0), cA, vA0); PG8_STAGE(PG8_SA(0, 1), cA, vA1);
    if (wr == 1) PG8_BAR;
    PG8_WAIT_V(2); PG8_BAR;
    PG8_STAGE(PG8_SB(1, 0), cB + kstep, vB); PG8_STAGE(PG8_SA(1, 0), cA + kstep, vA0); PG8_STAGE(PG8_SB(1, 1), cB + hstepB + kstep, vB);
    PG8_WAIT_V(6); PG8_BAR;
    for (;;) {
        const bool has_next = S.next(ui + 1, nxt);
        const GAS char* nA = has_next ? S.abase(nxt) : cA; const GAS char* nB = has_next ? S.bbase(nxt) : cB;
        if constexpr (GATHER) { if (has_next) { const GAS int* ri = S.rowidx(nxt);
#pragma unroll
            for (int i = 0; i < 2; ++i) { nA0[i] = (unsigned)(ri[Rst[i]] * lda_b + Cst[i] * 2); nA1[i] = (unsigned)(ri[HALF + Rst[i]] * lda_b + Cst[i] * 2); } }
            else {
#pragma unroll
                for (int i = 0; i < 2; ++i) { nA0[i] = vA0[i]; nA1[i] = vA1[i]; } } }
#pragma unroll 1
        for (int t = 0; t < nt; t += 2) {
            const bool last = (t == nt - 2);
            const bool skip = (t == 0) && (ui > 0);
            const GAS char* a1 = cA + (size_t)(t + 1) * kstep;
            const GAS char* a2 = last ? nA : cA + (size_t)(t + 2) * kstep; const GAS char* b2 = last ? nB : cB + (size_t)(t + 2) * kstep;
            const GAS char* a3 = a2 + kstep; const GAS char* b3 = b2 + kstep;
            unsigned wA0[2], wA1[2];
#pragma unroll
            for (int i = 0; i < 2; ++i) { wA0[i] = (GATHER && last) ? nA0[i] : vA0[i]; wA1[i] = (GATHER && last) ? nA1[i] : vA1[i]; }
            PG8_LDB(B0, 0, 0); PG8_LDB(B1, 0, 1); PG8_SCHED; PG8_LDA(At, 0, 0); if (!skip) { PG8_STAGE(PG8_SA(1, 1), a1, vA1); PG8_WAIT_V(8); }
            PG8_WAIT_L(0); PG8_BAR; PG8_MMA(0, 0, At, B0); PG8_MMA(0, 1, At, B1); PG8_BAR; PG8_SCHED;
            PG8_LDA(At, 0, 1); PG8_STAGE(PG8_SB(0, 0), b2, vB); PG8_STAGE(PG8_SB(0, 1), b2 + hstepB, vB); PG8_STAGE(PG8_SA(0, 0), a2, wA0);
            if (!skip) PG8_WAIT_V(8); PG8_WAIT_L(0); PG8_BAR; PG8_MMA(1, 0, At, B0); PG8_MMA(1, 1, At, B1); PG8_BAR; PG8_SCHED;
            PG8_LDB(B0, 1, 0); PG8_LDB(B1, 1, 1); PG8_SCHED; PG8_LDA(At, 1, 0); PG8_STAGE(PG8_SA(0, 1), a2, wA1);
            if (!skip) PG8_WAIT_V(8); PG8_WAIT_L(0); PG8_BAR; PG8_MMA(0, 0, At, B0); PG8_MMA(0, 1, At, B1); PG8_BAR; PG8_SCHED;
            PG8_LDA(At, 1, 1); PG8_STAGE(PG8_SB(1, 0), b3, vB); PG8_STAGE(PG8_SB(1, 1), b3 + hstepB, vB); PG8_STAGE(PG8_SA(1, 0), a3, wA0);
            if (!skip) PG8_WAIT_V(8); PG8_WAIT_L(0); PG8_BAR; PG8_MMA(1, 0, At, B0); PG8_MMA(1, 1, At, B1); PG8_BAR; PG8_SCHED;
        }
        { unsigned wA1[2];
#pragma unroll
          for (int i = 0; i < 2; ++i) wA1[i] = GATHER ? nA1[i] : vA1[i];
          PG8_STAGE(PG8_SA(1, 1), nA + kstep, wA1); }
        if (wr == 0) PG8_BAR;
        if constexpr (FP8) asm volatile("s_nop 15\n\ts_nop 15" ::: "memory");
        if constexpr (I8) {
            const GAS float* cs = S.colscale(cur) + wc * (Epi::WCONT ? 64 : 32); const GAS float* rsb = S.rowscale();
            f32x4 c0[2][2];
#pragma unroll
            for (int bj = 0; bj < 2; ++bj)
#pragma unroll
                for (int n = 0; n < 2; ++n) c0[bj][n] = *(const GAS f32x4*)(cs + bj * (Epi::WCONT ? 32 : HALF) + (Epi::PERM ? (8 * fq + 4 * n) : (16 * n + 4 * fq)));
#pragma unroll
            for (int ai = 0; ai < 2; ++ai)
#pragma unroll
                for (int m = 0; m < 4; ++m) { const int lr = ai * HALF + wr * 64 + m * 16 + fr; int grow;
                    if constexpr (GATHER) grow = S.rowidx(cur)[lr]; else grow = S.rowbase(cur) + lr;
                    const float rsv = rsb[grow];
#pragma unroll
                    for (int bj = 0; bj < 2; ++bj)
#pragma unroll
                        for (int n = 0; n < 2; ++n) { const f32x4 t = __builtin_convertvector(__builtin_bit_cast(i32x4, acc[ai][bj][m][n]), f32x4) * rsv; acc[ai][bj][m][n] = t * c0[bj][n]; } }
            asm volatile("" ::: "memory"); __builtin_amdgcn_sched_barrier(0);
        }
        PG8_WAIT_V(0);
        E(acc, cur, wr, wc, fr, fq);
        if (!has_next) break;
#pragma unroll
        for (int a = 0; a < 2; ++a)
#pragma unroll
            for (int b = 0; b < 2; ++b)
#pragma unroll
                for (int m = 0; m < 4; ++m)
#pragma unroll
                    for (int n = 0; n < 2; ++n) acc[a][b][m][n] = (f32x4){0.f, 0.f, 0.f, 0.f};
        cur = nxt; cA = nA; cB = nB; ++ui;
        if constexpr (GATHER) {
#pragma unroll
            for (int i = 0; i < 2; ++i) { vA0[i] = nA0[i]; vA1[i] = nA1[i]; } }
        if (wr == 1) PG8_BAR;
    }
    PG8_WAIT_V(0);
    PG8_BAR;
#undef PG8_SA
#undef PG8_SB
#undef PG8_STAGE
#undef PG8_LDA
#undef PG8_LDB
#undef PG8_MMA
#undef PG8_LD32
#undef PG8_WAIT_V
#undef PG8_WAIT_L
#undef PG8_BAR
#undef PG8_SCHED
}

typedef __bf16 bf16x2_t __attribute__((ext_vector_type(2)));
__device__ __forceinline__ unsigned cvt_pk_bf16(float lo, float hi) { f32x2 v = {lo, hi}; bf16x2_t b = __builtin_convertvector(v, bf16x2_t); return __builtin_bit_cast(unsigned, b); }

struct EpiStore {
    static constexpr bool PERM = true, WCONT = true;
    GAS bf16_t* O; int ldc; int rope; const GAS f32x2* ropetab; int row_off; LAS unsigned char* stg;
    __device__ __forceinline__ void operator()(const f32x4 (&acc)[2][2][4][2], const Unit& u, int wr, int wc, int fr, int fq) const {
        const int lane = fq * 16 + fr;
        LAS unsigned char* sb = stg + (wr * 4 + wc) * 2304;
        LAS unsigned char* wp = sb + fr * 144 + fq * 16;
        const LAS unsigned char* rp = sb + (lane >> 3) * 144 + (lane & 7) * 16;
        const int row0 = row_off + u.pm * BM + wr * 64; const int colw = u.pn * BM + wc * 64;
        GAS bf16_t* op = O + (size_t)(row0 + (lane >> 3)) * ldc + colw + (lane & 7) * 8;
#pragma unroll
        for (int ai = 0; ai < 2; ++ai)
#pragma unroll
            for (int m = 0; m < 4; ++m) { const int row = row0 + ai * HALF + m * 16 + fr;
#pragma unroll
                for (int bj = 0; bj < 2; ++bj) { f32x4 v0 = acc[ai][bj][m][0], v1 = acc[ai][bj][m][1];
                    if (rope && row < NL && (colw + bj * 32) < 640) {
                        const int l = row & (SEQ - 1); const int pos = bj ? (l & 63) : (l >> 6);
                        const GAS f32x2* tp = ropetab + pos * 16 + 4 * fq;
                        const f32x2 cs0 = tp[0], cs1 = tp[1], cs2 = tp[2], cs3 = tp[3];
                        f32x4 r0, r1;
                        r0[0] = v0[0] * cs0.x - v0[1] * cs0.y; r0[1] = v0[1] * cs0.x + v0[0] * cs0.y;
                        r0[2] = v0[2] * cs1.x - v0[3] * cs1.y; r0[3] = v0[3] * cs1.x + v0[2] * cs1.y;
                        r1[0] = v1[0] * cs2.x - v1[1] * cs2.y; r1[1] = v1[1] * cs2.x + v1[0] * cs2.y;
                        r1[2] = v1[2] * cs3.x - v1[3] * cs3.y; r1[3] = v1[3] * cs3.x + v1[2] * cs3.y;
                        v0 = r0; v1 = r1;
                    }
                    u32x4 w; w.x = cvt_pk_bf16(v0[0], v0[1]); w.y = cvt_pk_bf16(v0[2], v0[3]); w.z = cvt_pk_bf16(v1[0], v1[1]); w.w = cvt_pk_bf16(v1[2], v1[3]);
                    *(LAS u32x4*)(wp + bj * 64) = w; }
                __builtin_amdgcn_wave_barrier();
                const u32x4 q0 = *(const LAS u32x4*)rp, q1 = *(const LAS u32x4*)(rp + 8 * 144);
                __builtin_amdgcn_wave_barrier();
                GAS bf16_t* o = op + (size_t)(ai * HALF + m * 16) * ldc;
                __builtin_nontemporal_store(q0, (GAS u32x4*)o); __builtin_nontemporal_store(q1, (GAS u32x4*)(o + (size_t)8 * ldc)); }
    }
};
struct EpiGate {
    static constexpr bool PERM = true, WCONT = true;
    const GAS bf16_t* P; const GAS float* bgate; GAS bf16_t* M; LAS unsigned char* stg;
    __device__ __forceinline__ void operator()(const f32x4 (&acc)[2][2][4][2], const Unit& u, int wr, int wc, int fr, int fq) const {
        const int lane = fq * 16 + fr;
        LAS unsigned char* grp = stg + wr * 9216;
        LAS unsigned char* wp = grp + wc * 2304 + fr * 144 + fq * 16;
        const int rr = 4 * wc + (lane >> 4), dq = lane & 15;
        const LAS unsigned char* rp = grp + rr * 144 + dq * 8;
        const int row0 = u.pm * BM + wr * 64;
        const GAS bf16_t* pp = P + (size_t)(row0 + fr) * 4096 + wc * 1024 + u.pn * 64 + 8 * fq;
        GAS bf16_t* mp = M + (size_t)(row0 + rr) * 1024 + u.pn * 64 + 4 * dq;
        f32x4 bg[2][2];
#pragma unroll
        for (int bj = 0; bj < 2; ++bj)
#pragma unroll
            for (int nn = 0; nn < 2; ++nn) bg[bj][nn] = *(const GAS f32x4*)(bgate + wc * 1024 + u.pn * 64 + bj * 32 + 8 * fq + 4 * nn);
        u32x4 pnx[2];
#pragma unroll
        for (int bj = 0; bj < 2; ++bj) pnx[bj] = *(const GAS u32x4*)(pp + bj * 32);
#pragma unroll
        for (int st = 0; st < 8; ++st) { const int ai = st >> 2, m = st & 3;
            u32x4 pc[2];
#pragma unroll
            for (int bj = 0; bj < 2; ++bj) pc[bj] = pnx[bj];
            if (st + 1 < 8) { const int a2 = (st + 1) >> 2, m2 = (st + 1) & 3;
#pragma unroll
                for (int bj = 0; bj < 2; ++bj) pnx[bj] = *(const GAS u32x4*)(pp + (size_t)(a2 * HALF + m2 * 16) * 4096 + bj * 32); }
#pragma unroll
            for (int bj = 0; bj < 2; ++bj) { const f32x4 a0 = acc[ai][bj][m][0] + bg[bj][0], a1 = acc[ai][bj][m][1] + bg[bj][1]; const u32x4 pq = pc[bj];
                u32x4 w; w.x = cvt_pk_bf16(sigmoid_f(a0[0]) * bflo(pq.x), sigmoid_f(a0[1]) * bfhi(pq.x)); w.y = cvt_pk_bf16(sigmoid_f(a0[2]) * bflo(pq.y), sigmoid_f(a0[3]) * bfhi(pq.y));
                w.z = cvt_pk_bf16(sigmoid_f(a1[0]) * bflo(pq.z), sigmoid_f(a1[1]) * bfhi(pq.z)); w.w = cvt_pk_bf16(sigmoid_f(a1[2]) * bflo(pq.w), sigmoid_f(a1[3]) * bfhi(pq.w));
                *(LAS u32x4*)(wp + bj * 64) = w; }
            asm volatile("s_waitcnt lgkmcnt(0)" ::: "memory"); __builtin_amdgcn_s_barrier(); asm volatile("" ::: "memory");
            f32x4 sm = {0.f, 0.f, 0.f, 0.f};
#pragma unroll
            for (int w4 = 0; w4 < 4; ++w4) { const u32x2 t = *(const LAS u32x2*)(rp + w4 * 2304); sm[0] += bflo(t.x); sm[1] += bfhi(t.x); sm[2] += bflo(t.y); sm[3] += bfhi(t.y); }
            u32x2 o; o.x = cvt_pk_bf16(sm[0], sm[1]); o.y = cvt_pk_bf16(sm[2], sm[3]);
            *(GAS u32x2*)(mp + (size_t)(ai * HALF + m * 16) * 1024) = o;
            asm volatile("s_waitcnt lgkmcnt(0)" ::: "memory"); __builtin_amdgcn_s_barrier(); asm volatile("" ::: "memory");
        }
    }
};
struct EpiResid {
    static constexpr bool PERM = true, WCONT = false;
    GAS bf16_t* xr; const GAS float* sl; const GAS float* sc; int srcf32; const GAS float* mod;
    __device__ __forceinline__ void operator()(const f32x4 (&acc)[2][2][4][2], const Unit& u, int wr, int wc, int fr, int fq) const {
        const int row0 = u.pm * BM + wr * 64 + fr; const int col0 = u.pn * BM + wc * 32 + 8 * fq;
        const int mrow = (u.pm < 128) ? (u.pm >> 5) : 4;
        const GAS float* mp = mod + (size_t)mrow * 6144 + 2 * 1024;
#pragma unroll
        for (int bj = 0; bj < 2; ++bj) { const int c = col0 + bj * HALF; const f32x4 g0 = *(const GAS f32x4*)(mp + c), g1 = *(const GAS f32x4*)(mp + c + 4);
#pragma unroll
            for (int ai = 0; ai < 2; ++ai)
#pragma unroll
                for (int m = 0; m < 4; ++m) { const int row = row0 + ai * HALF + m * 16;
                    f32x4 x0, x1;
                    if (srcf32) { const GAS float* xp = ((row < NL) ? sl + (size_t)row * 1024 : sc + (size_t)(row - NL) * 1024) + c; x0 = *(const GAS f32x4*)xp; x1 = *(const GAS f32x4*)(xp + 4); }
                    else { const u32x4 w = *(const GAS u32x4*)(xr + (size_t)row * 1024 + c); x0 = (f32x4){bflo(w.x), bfhi(w.x), bflo(w.y), bfhi(w.y)}; x1 = (f32x4){bflo(w.z), bfhi(w.z), bflo(w.w), bfhi(w.w)}; }
                    x0 = x0 + g0 * acc[ai][bj][m][0]; x1 = x1 + g1 * acc[ai][bj][m][1];
                    u32x4 o; o.x = cvt_pk_bf16(x0[0], x0[1]); o.y = cvt_pk_bf16(x0[2], x0[3]); o.z = cvt_pk_bf16(x1[0], x1[1]); o.w = cvt_pk_bf16(x1[2], x1[3]);
                    *(GAS u32x4*)(xr + (size_t)row * 1024 + c) = o; } }
    }
};
struct EpiSwiglu {
    static constexpr bool PERM = true, WCONT = false;
    GAS unsigned char* act;
    __device__ __forceinline__ void operator()(const f32x4 (&acc)[2][2][4][2], const Unit& u, int wr, int wc, int fr, int fq) const {
        const int row0 = u.pm * BM + wr * 64 + fr; const int col0 = u.pn * 128 + wc * 32 + 8 * fq;
#pragma unroll
        for (int ai = 0; ai < 2; ++ai)
#pragma unroll
            for (int m = 0; m < 4; ++m) { const int row = row0 + ai * HALF + m * 16;
                const f32x4 a0 = acc[ai][0][m][0], a1 = acc[ai][0][m][1], b0 = acc[ai][1][m][0] * 8.f, b1 = acc[ai][1][m][1] * 8.f;
                f32x4 y0, y1;
#pragma unroll
                for (int e = 0; e < 4; ++e) { y0[e] = fminf(fmaxf(silu_f(a0[e]) * b0[e], -448.f), 448.f); y1[e] = fminf(fmaxf(silu_f(a1[e]) * b1[e], -448.f), 448.f); }
                u32x2 w; w.x = pk4_fp8(y0[0], y0[1], y0[2], y0[3]); w.y = pk4_fp8(y1[0], y1[1], y1[2], y1[3]);
                *(GAS u32x2*)(act + (size_t)row * 512 + col0) = w; }
    }
};
struct SchedDense { DenseOrder o; const GAS char* A; const GAS char* Bt; size_t a_tile, b_tile; size_t a_colgrp; int colgrp_shift; const GAS float* cs; const GAS float* rs;
    __device__ __forceinline__ const GAS float* colscale(const Unit& u) const { return cs + u.pn * 256; }
    __device__ __forceinline__ const GAS float* rowscale() const { return rs; }
    __device__ __forceinline__ int rowbase(const Unit& u) const { return u.pm * 256; }
    __device__ __forceinline__ bool next(int i, Unit& u) const { return o.next(i, u); }
    __device__ __forceinline__ const GAS char* abase(const Unit& u) const { return A + (size_t)u.pm * a_tile + (size_t)(u.pn >> colgrp_shift) * a_colgrp; }
    __device__ __forceinline__ const GAS char* bbase(const Unit& u) const { return Bt + (size_t)u.pn * b_tile; }
    __device__ __forceinline__ const GAS int* rowidx(const Unit&) const { return nullptr; }
};
struct SchedMoe {
    int G, c; const GAS char* A; const GAS char* Bt; const GAS int* rowtok; const GAS int* xinfo; size_t a_tile, e_stride, b_tile; const GAS float* cs; const GAS float* rs;
    __device__ __forceinline__ const GAS float* colscale(const Unit& u) const { return cs + u.aux * 1024 + u.pn * 256; }
    __device__ __forceinline__ const GAS float* rowscale() const { return rs; }
    __device__ __forceinline__ int rowbase(const Unit& u) const { return u.pm * 256; }
    __device__ __forceinline__ bool next(int i, Unit& u) const {
        const int x = c & 7, j = c >> 3, per = G >> 3; const int k = i * per + j; const GAS int* xi = xinfo + x * 16;
        const int p1 = xi[1], p2 = xi[2], p3 = xi[3], p4 = xi[4];
        if (k >= 4 * p4) return false;
        const int tl = k >> 2; const int q = (tl >= p3) ? 3 : (tl >= p2) ? 2 : (tl >= p1) ? 1 : 0; const int pq = (q == 3) ? p3 : (q == 2) ? p2 : (q == 1) ? p1 : 0;
        u.pm = xi[8 + q] + (tl - pq); u.pn = k & 3; u.aux = x + 8 * q; return true; }
    __device__ __forceinline__ const GAS char* abase(const Unit& u) const { return A + (size_t)u.pm * a_tile; }
    __device__ __forceinline__ const GAS char* bbase(const Unit& u) const { return Bt + (size_t)u.aux * e_stride + (size_t)u.pn * b_tile; }
    __device__ __forceinline__ const GAS int* rowidx(const Unit& u) const { return rowtok + u.pm * 256; }
};
}

struct Ctx {
    LAS unsigned char* lds; int tid, lane, wave, gw, ngw, bid, nblk, vbid;
    const LAS Params* p;
};

__device__ __forceinline__ void ph_tables(const Ctx& c, GAS unsigned char* ws) {
    const int gt = c.bid * 512 + c.tid, ngt = c.nblk * 512;
    GAS f32x2* rope = (GAS f32x2*)(ws + OFF_ROPE); GAS f32x2* tw = (GAS f32x2*)(ws + OFF_TW);
    for (int i = gt; i < 2048; i += ngt) { const int pos = i >> 4, fi = i & 15; const float invf = powf(10000.f, -(float)fi / 16.f); const float a = (float)pos * invf; rope[i] = (f32x2){cosf(a), sinf(a)}; }
    for (int i = gt; i < 8192; i += ngt) { const float x = (float)i / 4096.f; tw[i] = (f32x2){cospif(x), sinpif(x)}; }
    GAS bf16_t* f64 = (GAS bf16_t*)(ws + OFF_F64); GAS bf16_t* f128 = (GAS bf16_t*)(ws + OFF_F128);
    for (int i = gt; i < 4096; i += ngt) { const int m = i >> 6, cc = i & 63; const float x = (float)((m * cc) & 63) / 32.f; f64[i] = (bf16_t)f2bf(cospif(x)); f64[4096 + i] = (bf16_t)f2bf(sinpif(x)); }
    for (int i = gt; i < 16384; i += ngt) { const int k = i >> 7, l = i & 127; const float x = (float)((k * l) & 127) / 64.f; f128[i] = (bf16_t)f2bf(cospif(x)); f128[16384 + i] = (bf16_t)f2bf(sinpif(x)); }
    GAS bf16_t* f256 = (GAS bf16_t*)(ws + OFF_F256);
    for (int i = gt; i < 65536; i += ngt) { const int k = i >> 8, l = i & 255; const float x = (float)((k * l) & 255) / 128.f; f256[i] = (bf16_t)f2bf(cospif(x)); f256[65536 + i] = (bf16_t)f2bf(sinpif(x)); }
    GAS unsigned* ctl = (GAS unsigned*)(ws + OFF_CTL);
    for (int i = gt; i < 256; i += ngt) ctl[i] = 0u;
}

__device__ __forceinline__ void ph_mod(const Ctx& c, GAS unsigned char* ws) {
    const LAS Params& P = *c.p;
    LAS float* sc = (LAS float*)c.lds;
    LAS float* red = sc + 5 * 1024;
    for (int i = c.tid; i < 5 * 1024; i += 512) { const float v = (i < 4096) ? gp(P.in[I_C])[i] : gp(P.in[I_CCTX])[i - 4096]; sc[i] = silu_f(v); }
    __syncthreads();
    GAS float* MOD = (GAS float*)(ws + OFF_MOD);
    for (int grp = c.bid; grp < 512; grp += c.nblk) {
        const int L = grp >> 8, j0 = (grp & 255) * 24;
        const GAS float* W = gp(P.in[I_WADA]) + (size_t)L * 1024 * 6144;
        const int kk = c.tid / 24, jj = c.tid % 24;
        float a0 = 0.f, a1 = 0.f, a2 = 0.f, a3 = 0.f, a4 = 0.f;
        if (kk < 21) for (int k = kk; k < 1024; k += 21) { const float w = W[(size_t)k * 6144 + j0 + jj]; a0 += sc[k] * w; a1 += sc[1024 + k] * w; a2 += sc[2048 + k] * w; a3 += sc[3072 + k] * w; a4 += sc[4096 + k] * w; }
        if (kk < 21) { LAS float* r = red + (kk * 24 + jj) * 5; r[0] = a0; r[1] = a1; r[2] = a2; r[3] = a3; r[4] = a4; }
        __syncthreads();
        if (c.tid < 120) { const int j = c.tid % 24, r = c.tid / 24; float s = gp(P.in[I_BADA])[L * 6144 + j0 + j];
            for (int q = 0; q < 21; ++q) s += red[(q * 24 + j) * 5 + r];
            MOD[((size_t)L * 5 + r) * 6144 + j0 + j] = s; }
        __syncthreads();
    }
}

__device__ __forceinline__ int wrow_in(int cidx) {
    if (cidx < 640) { const int hb = cidx & ~63, d = cidx & 63; return hb + ((d < 32) ? 2 * d : 2 * (d - 32) + 1); }
    return cidx;
}
__device__ __forceinline__ int wrow_gate(int cidx) {
    const int n = cidx >> 10, d = cidx & 1023, dl = d & 63;
    return (d >> 6) * 256 + 64 * n + dl;
}
template <int MAP, bool F8 = false>
__device__ __forceinline__ void transpose_item(const GAS float* W, int ldw, int K, GAS void* WTv, int row_base, LAS float* scr, int kb, int nb, int lane) {
    const int k0 = 64 * kb, n0 = 32 * nb;
    { f32x4 t[8];
#pragma unroll
      for (int i = 0; i < 8; ++i) t[i] = *(const GAS f32x4*)(W + (size_t)(k0 + 8 * i + (lane >> 3)) * ldw + n0 + 4 * (lane & 7));
#pragma unroll
      for (int i = 0; i < 8; ++i) { LAS float* d = scr + (8 * i + (lane >> 3)) * 33 + 4 * (lane & 7); d[0] = t[i].x; d[1] = t[i].y; d[2] = t[i].z; d[3] = t[i].w; } }
    asm volatile("s_waitcnt lgkmcnt(0)" ::: "memory");
    const int cch = lane & 7;
#pragma unroll
    for (int j = 0; j < 4; ++j) { const int n = (lane >> 3) + 8 * j; const LAS float* s = scr + (8 * cch) * 33 + n;
        const int cidx = n0 + n; int r;
        if (MAP == 1) r = wrow_in(cidx); else if (MAP == 2) r = wrow_gate(cidx); else if (MAP == 3) r = (cidx >> 7) * 256 + (cidx & 127); else r = cidx;
        if (F8) { u32x2 o; o.x = pk4_fp8(s[0 * 33] * 32.f, s[1 * 33] * 32.f, s[2 * 33] * 32.f, s[3 * 33] * 32.f); o.y = pk4_fp8(s[4 * 33] * 32.f, s[5 * 33] * 32.f, s[6 * 33] * 32.f, s[7 * 33] * 32.f);
            *(GAS u32x2*)((GAS unsigned char*)WTv + (size_t)(row_base + r) * K + k0 + 8 * cch) = o; }
        else { u32x4 o; o.x = pk2(s[0 * 33], s[1 * 33]); o.y = pk2(s[2 * 33], s[3 * 33]); o.z = pk2(s[4 * 33], s[5 * 33]); o.w = pk2(s[6 * 33], s[7 * 33]);
            *(GAS u32x4*)((GAS bf16_t*)WTv + (size_t)(row_base + r) * K + k0 + 8 * cch) = o; } }
    asm volatile("s_waitcnt lgkmcnt(0)" ::: "memory");
}
template <int MAP> __device__ __forceinline__ int strip_row(int cidx) {
    if (MAP == 1) return wrow_in(cidx); else if (MAP == 2) return wrow_gate(cidx); else if (MAP == 3) return (cidx >> 7) * 256 + (cidx & 127); else return cidx;
}
template <int MAP>
__device__ __forceinline__ void strip_i8(const GAS float* W, int ldw, int K, GAS unsigned char* WT, GAS float* CS, int row_base, LAS float* scr, int nb, int lane) {
    const int n0 = 32 * nb, r8 = lane >> 3, c4 = lane & 7;
    const GAS float* wp = W + (size_t)r8 * ldw + n0 + 4 * c4;
    f32x4 m4 = {0.f, 0.f, 0.f, 0.f};
    for (int k = 0; k < K; k += 128) {
        f32x4 v[16];
#pragma unroll
        for (int u = 0; u < 16; ++u) v[u] = *(const GAS f32x4*)(wp + (size_t)(k + 8 * u) * ldw);
#pragma unroll
        for (int u = 0; u < 16; ++u) { m4.x = fmaxf(m4.x, fabsf(v[u].x)); m4.y = fmaxf(m4.y, fabsf(v[u].y)); m4.z = fmaxf(m4.z, fabsf(v[u].z)); m4.w = fmaxf(m4.w, fabsf(v[u].w)); }
    }
#pragma unroll
    for (int o = 8; o < 64; o <<= 1) { m4.x = fmaxf(m4.x, __shfl_xor(m4.x, o)); m4.y = fmaxf(m4.y, __shfl_xor(m4.y, o)); m4.z = fmaxf(m4.z, __shfl_xor(m4.z, o)); m4.w = fmaxf(m4.w, __shfl_xor(m4.w, o)); }
    LAS float* invs = scr + 64 * 33;
    if (lane < 8) {
#pragma unroll
        for (int e = 0; e < 4; ++e) { const float m = fmaxf(m4[e], 1e-20f); invs[4 * c4 + e] = 127.f / m; CS[row_base + strip_row<MAP>(n0 + 4 * c4 + e)] = m * (1.f / 127.f); } }
    const int nk = K / 64; f32x4 t[8];
#pragma unroll
    for (int i = 0; i < 8; ++i) t[i] = *(const GAS f32x4*)(wp + (size_t)(8 * i) * ldw);
    for (int kb = 0; kb < nk; ++kb) {
        const int k0 = 64 * kb;
#pragma unroll
        for (int i = 0; i < 8; ++i) { LAS float* d = scr + (8 * i + r8) * 33 + 4 * c4; d[0] = t[i].x; d[1] = t[i].y; d[2] = t[i].z; d[3] = t[i].w; }
        if (kb + 1 < nk) {
#pragma unroll
            for (int i = 0; i < 8; ++i) t[i] = *(const GAS f32x4*)(wp + (size_t)(k0 + 64 + 8 * i) * ldw); }
        asm volatile("s_waitcnt lgkmcnt(0)" ::: "memory");
        const int cch = lane & 7;
#pragma unroll
        for (int j = 0; j < 4; ++j) { const int n = (lane >> 3) + 8 * j; const LAS float* sp = scr + (8 * cch) * 33 + n; const float inv = invs[n];
            const int r = strip_row<MAP>(n0 + n);
            u32x2 o; o.x = pk4_i8(sp[0 * 33] * inv, sp[1 * 33] * inv, sp[2 * 33] * inv, sp[3 * 33] * inv); o.y = pk4_i8(sp[4 * 33] * inv, sp[5 * 33] * inv, sp[6 * 33] * inv, sp[7 * 33] * inv);
            *(GAS u32x2*)(WT + (size_t)(row_base + r) * K + k0 + 8 * cch) = o; }
        asm volatile("s_waitcnt lgkmcnt(0)" ::: "memory");
    }
}
struct StripDesc { const GAS float* W; int ldw; GAS unsigned char* WT; GAS float* CS; int row_base; int nb; int map; };
__device__ __forceinline__ int strip_row_rt(int map, int cidx) {
    if (map == 1) return wrow_in(cidx); if (map == 2) return wrow_gate(cidx); if (map == 3) return (cidx >> 7) * 256 + (cidx & 127); return cidx;
}
__device__ __forceinline__ void strip_load(const StripDesc& d, int wave, int lane, f32x4 (&t)[16]) {
    const GAS float* wp = d.W + (size_t)(128 * wave + (lane >> 3)) * d.ldw + 32 * d.nb + 4 * (lane & 7);
#pragma unroll
    for (int u = 0; u < 16; ++u) t[u] = __builtin_nontemporal_load((const GAS f32x4*)(wp + (size_t)(8 * u) * d.ldw));
}
__device__ __forceinline__ void strip_finish(const StripDesc& d, const f32x4 (&t)[16], LAS float* scr, LAS float* red, int wave, int lane) {
    const int n0 = 32 * d.nb, r8 = lane >> 3, c4 = lane & 7;
    f32x4 m4 = {0.f, 0.f, 0.f, 0.f};
#pragma unroll
    for (int u = 0; u < 16; ++u) { m4.x = fmaxf(m4.x, fabsf(t[u].x)); m4.y = fmaxf(m4.y, fabsf(t[u].y)); m4.z = fmaxf(m4.z, fabsf(t[u].z)); m4.w = fmaxf(m4.w, fabsf(t[u].w)); }
#pragma unroll
    for (int o = 8; o < 64; o <<= 1) { m4.x = fmaxf(m4.x, __shfl_xor(m4.x, o)); m4.y = fmaxf(m4.y, __shfl_xor(m4.y, o)); m4.z = fmaxf(m4.z, __shfl_xor(m4.z, o)); m4.w = fmaxf(m4.w, __shfl_xor(m4.w, o)); }
    if (lane < 8) { LAS float* rp = red + wave * 32 + 4 * c4; rp[0] = m4.x; rp[1] = m4.y; rp[2] = m4.z; rp[3] = m4.w; }
    __syncthreads();
    LAS float* invs = scr + 64 * 33;
    if (lane < 32) { float m = red[lane];
#pragma unroll
        for (int w = 1; w < 8; ++w) m = fmaxf(m, red[w * 32 + lane]);
        m = fmaxf(m, 1e-20f); invs[lane] = 127.f / m;
        if (wave == 0) d.CS[d.row_base + strip_row_rt(d.map, n0 + lane)] = m * (1.f / 127.f); }
    asm volatile("s_waitcnt lgkmcnt(0)" ::: "memory");
#pragma unroll
    for (int kb = 0; kb < 2; ++kb) {
        const int k0 = 128 * wave + 64 * kb;
#pragma unroll
        for (int i = 0; i < 8; ++i) { LAS float* dd = scr + (8 * i + r8) * 33 + 4 * c4; const f32x4 v = t[8 * kb + i]; dd[0] = v.x; dd[1] = v.y; dd[2] = v.z; dd[3] = v.w; }
        asm volatile("s_waitcnt lgkmcnt(0)" ::: "memory");
        const int cch = lane & 7;
#pragma unroll
        for (int j = 0; j < 4; ++j) { const int n = (lane >> 3) + 8 * j; const LAS float* sp = scr + (8 * cch) * 33 + n; const float inv = invs[n];
            const int r = strip_row_rt(d.map, n0 + n);
            u32x2 o; o.x = pk4_i8(sp[0 * 33] * inv, sp[1 * 33] * inv, sp[2 * 33] * inv, sp[3 * 33] * inv); o.y = pk4_i8(sp[4 * 33] * inv, sp[5 * 33] * inv, sp[6 * 33] * inv, sp[7 * 33] * inv);
            *(GAS u32x2*)(d.WT + (size_t)(d.row_base + r) * 1024 + k0 + 8 * cch) = o; }
        asm volatile("s_waitcnt lgkmcnt(0)" ::: "memory");
    }
}
struct TrDesc { const GAS float* W; int ldw; int K; GAS void* WT; int row_base; int kb; int nb; int f8; };
__device__ __forceinline__ void tr_load(const TrDesc& d, int lane, f32x4 (&t)[8]) {
#pragma unroll
    for (int i = 0; i < 8; ++i) t[i] = __builtin_nontemporal_load((const GAS f32x4*)(d.W + (size_t)(64 * d.kb + 8 * i + (lane >> 3)) * d.ldw + 32 * d.nb + 4 * (lane & 7)));
}
__device__ __forceinline__ void tr_finish(const TrDesc& d, const f32x4 (&t)[8], LAS float* scr, int lane) {
    const int k0 = 64 * d.kb, n0 = 32 * d.nb;
#pragma unroll
    for (int i = 0; i < 8; ++i) { LAS float* dd = scr + (8 * i + (lane >> 3)) * 33 + 4 * (lane & 7); dd[0] = t[i].x; dd[1] = t[i].y; dd[2] = t[i].z; dd[3] = t[i].w; }
    asm volatile("s_waitcnt lgkmcnt(0)" ::: "memory");
    const int cch = lane & 7;
#pragma unroll
    for (int j = 0; j < 4; ++j) { const int n = (lane >> 3) + 8 * j; const LAS float* sp = scr + (8 * cch) * 33 + n; const int r = n0 + n;
        if (d.f8) { u32x2 o; o.x = pk4_fp8(sp[0 * 33] * 32.f, sp[1 * 33] * 32.f, sp[2 * 33] * 32.f, sp[3 * 33] * 32.f); o.y = pk4_fp8(sp[4 * 33] * 32.f, sp[5 * 33] * 32.f, sp[6 * 33] * 32.f, sp[7 * 33] * 32.f);
            *(GAS u32x2*)((GAS unsigned char*)d.WT + (size_t)(d.row_base + r) * d.K + k0 + 8 * cch) = o; }
        else { u32x4 o; o.x = pk2(sp[0 * 33], sp[1 * 33]); o.y = pk2(sp[2 * 33], sp[3 * 33]); o.z = pk2(sp[4 * 33], sp[5 * 33]); o.w = pk2(sp[6 * 33], sp[7 * 33]);
            *(GAS u32x4*)((GAS bf16_t*)d.WT + (size_t)(d.row_base + r) * d.K + k0 + 8 * cch) = o; } }
    asm volatile("s_waitcnt lgkmcnt(0)" ::: "memory");
}
__device__ __forceinline__ void ph_weights(const Ctx& c, GAS unsigned char* ws, int L, int s_lo = 0, int s_hi = 1 << 30, int t_lo = 0, int t_hi = 1 << 30, int blk = -1, int nb = 0, bool w2alt = false) {
    if (blk < 0) { blk = c.bid; nb = c.nblk; }
    const int gwv = blk * 8 + c.wave, ngwv = nb * 8;
    const LAS Params& P = *c.p;
    LAS float* scr = (LAS float*)(c.lds + c.wave * 16384);
    LAS float* redb = (LAS float*)(c.lds + 8 * 16384);
    GAS unsigned char* wb = ws + OFF_W;
    GAS unsigned char* Win8 = wb + W_IN; GAS unsigned char* Wg = wb + W_GATE; GAS bf16_t* Wbr = (GAS bf16_t*)(wb + W_BR); GAS bf16_t* Wo = (GAS bf16_t*)(wb + W_O);
    GAS unsigned char* W13 = wb + W_13; GAS unsigned char* W2 = w2alt ? ws + OFF_W2B : wb + W_2;
    const GAS float* win = gp(P.in[I_WIN]) + (size_t)L * 1024 * INW;
    const GAS float* wg = gp(P.in[I_WGATE]) + (size_t)L * 1024 * 4096;
    const GAS float* wbr = gp(P.in[I_WBR]) + (size_t)L * 4 * 512 * 1024;
    const GAS float* wo = gp(P.in[I_WO]) + (size_t)L * 1024 * 1024;
    const GAS float* w1 = gp(P.in[I_W1]) + (size_t)L * NE * 1024 * 512;
    const GAS float* w3 = gp(P.in[I_W3]) + (size_t)L * NE * 1024 * 512;
    const GAS float* w2 = gp(P.in[I_W2]) + (size_t)L * NE * 512 * 1024;
    GAS float* CS = (GAS float*)(ws + OFF_CS);
    constexpr int S_IN = 64, S_G = 128, S_E = 512, NSTRIP_ALL = 2 * S_IN + S_G + 2 * S_E;
    auto sdesc = [&](int it) -> StripDesc { int r = it; StripDesc d;
        if (r < S_IN) { d = StripDesc{win, INW, Win8, CS, 0, r, 1}; return d; } r -= S_IN;
        if (r < S_IN) { d = StripDesc{win + 2064, INW, Win8, CS, 2048, r, 0}; return d; } r -= S_IN;
        if (r < S_G) { d = StripDesc{wg, 4096, Wg, CS + 4096, 0, r, 2}; return d; } r -= S_G;
        if (r < S_E) { const int e = r >> 4, q = r & 15; d = StripDesc{w1 + (size_t)e * 1024 * 512, 512, W13, CS + 8192, e * 1024, q, 3}; return d; } r -= S_E;
        { const int e = r >> 4, q = r & 15; d = StripDesc{w3 + (size_t)e * 1024 * 512, 512, W13, CS + 8192, e * 1024 + 128, q, 3}; return d; } };
    __syncthreads();
    { f32x4 ta[16], tb[16]; StripDesc da, db; int it = s_lo + blk, par = 0; const int NSTRIP = min(NSTRIP_ALL, s_hi);
      if (it < NSTRIP) { da = sdesc(it); strip_load(da, c.wave, c.lane, ta); }
      while (it < NSTRIP) {
          const int n1 = it + nb; if (n1 < NSTRIP) { db = sdesc(n1); strip_load(db, c.wave, c.lane, tb); }
          strip_finish(da, ta, scr, redb + (par & 1) * 256, c.wave, c.lane); ++par;
          if (n1 >= NSTRIP) break;
          const int n2 = n1 + nb; if (n2 < NSTRIP) { da = sdesc(n2); strip_load(da, c.wave, c.lane, ta); }
          strip_finish(db, tb, scr, redb + (par & 1) * 256, c.wave, c.lane); ++par;
          it = n2; } }
    constexpr int N_BR = 1024, N_O = 512, N_W2 = 8192;
    constexpr int TOTAL_ALL = N_BR + N_O + N_W2; const int TOTAL = min(TOTAL_ALL, t_hi);
    auto tdesc = [&](int it) -> TrDesc { int r = it; TrDesc d;
        if (r < N_BR) { const int n = r >> 8, q = r & 255; d = TrDesc{wbr + (size_t)n * 512 * 1024, 1024, 512, (GAS void*)Wbr, n * 1024, q / 32, q % 32, 0}; return d; } r -= N_BR;
        if (r < N_O) { d = TrDesc{wo, 1024, 1024, (GAS void*)Wo, 0, r / 32, r % 32, 0}; return d; } r -= N_O;
        { const int e = r >> 8, q = r & 255; d = TrDesc{w2 + (size_t)e * 512 * 1024, 1024, 512, (GAS void*)W2, e * 1024, q / 32, q % 32, 1}; return d; } };
    { f32x4 ta[8], tb[8]; TrDesc da, db; int it = t_lo + gwv;
      if (it < TOTAL) { da = tdesc(it); tr_load(da, c.lane, ta); }
      while (it < TOTAL) {
          const int n1 = it + ngwv; if (n1 < TOTAL) { db = tdesc(n1); tr_load(db, c.lane, tb); }
          tr_finish(da, ta, scr, c.lane);
          if (n1 >= TOTAL) break;
          const int n2 = n1 + ngwv; if (n2 < TOTAL) { da = tdesc(n2); tr_load(da, c.lane, ta); }
          tr_finish(db, tb, scr, c.lane);
          it = n2; } }
}

__device__ __forceinline__ const GAS float* mod_row(const GAS unsigned char* ws, int L, int row) { const int r = (row < NL) ? (row >> 13) : 4; return (const GAS float*)(ws + OFF_MOD) + ((size_t)L * 5 + r) * 6144; }
__device__ __forceinline__ void load_xr(GAS unsigned char* ws, int row, int lane, u32x2 (&r)[4]) {
    const GAS bf16_t* xr = (const GAS bf16_t*)(ws + OFF_XR) + (size_t)row * 1024;
#pragma unroll
    for (int j = 0; j < 4; ++j) r[j] = *(const GAS u32x2*)(xr + 4 * lane + 256 * j);
}
__device__ __forceinline__ f32x4 unpack4(u32x2 w) { return (f32x4){bflo(w.x), bfhi(w.x), bflo(w.y), bfhi(w.y)}; }

__device__ __forceinline__ void norm_mod(f32x4 (&v)[4], const GAS float* g, const GAS float* shift, const GAS float* scale, int lane) {
    float ss = 0.f;
#pragma unroll
    for (int j = 0; j < 4; ++j) ss += (v[j].x * v[j].x + v[j].y * v[j].y) + (v[j].z * v[j].z + v[j].w * v[j].w);
    const float rs = rsqrtf(wave_sum(ss) * (1.f / 1024.f) + EPS);
#pragma unroll
    for (int j = 0; j < 4; ++j) { const int idx = 4 * lane + 256 * j; const f32x4 gg = *(const GAS f32x4*)(g + idx);
        f32x4 y = v[j] * rs * gg;
        if (shift) { const f32x4 sh = *(const GAS f32x4*)(shift + idx), sc = *(const GAS f32x4*)(scale + idx); y = y * (sc + 1.f) + sh; }
        v[j] = y; }
}
struct ModVec { f32x4 G[4], S[4]; };
__device__ __forceinline__ void modvec_load(ModVec& M, const GAS float* g, const GAS float* shift, const GAS float* scale, int lane) {
#pragma unroll
    for (int j = 0; j < 4; ++j) { const int idx = 4 * lane + 256 * j; const f32x4 gg = *(const GAS f32x4*)(g + idx);
        if (shift) { const f32x4 sh = *(const GAS f32x4*)(shift + idx), sc = *(const GAS f32x4*)(scale + idx); M.G[j] = gg * (sc + 1.f); M.S[j] = sh; }
        else { M.G[j] = gg; M.S[j] = (f32x4){0.f, 0.f, 0.f, 0.f}; } }
}
__device__ __forceinline__ void norm_apply(f32x4 (&v)[4], const ModVec& M) {
    float ss = 0.f;
#pragma unroll
    for (int j = 0; j < 4; ++j) ss += (v[j].x * v[j].x + v[j].y * v[j].y) + (v[j].z * v[j].z + v[j].w * v[j].w);
    const float rs = rsqrtf(wave_sum(ss) * (1.f / 1024.f) + EPS);
#pragma unroll
    for (int j = 0; j < 4; ++j) v[j] = v[j] * rs * M.G[j] + M.S[j];
}
__device__ __forceinline__ int mod_index(int row) { return (row < NL) ? (row >> 13) : 4; }
__device__ __forceinline__ void store_row_bf16(GAS bf16_t* dst, const f32x4 (&v)[4], int lane) {
#pragma unroll
    for (int j = 0; j < 4; ++j) { u32x2 w; w.x = pk2(v[j].x, v[j].y); w.y = pk2(v[j].z, v[j].w); *(GAS u32x2*)(dst + 4 * lane + 256 * j) = w; }
}
__device__ __forceinline__ void store_row_i8(GAS unsigned char* dst, GAS float* hs, const f32x4 (&v)[4], int lane) {
    float m = 0.f;
#pragma unroll
    for (int j = 0; j < 4; ++j) m = fmaxf(fmaxf(m, fmaxf(fabsf(v[j].x), fabsf(v[j].y))), fmaxf(fabsf(v[j].z), fabsf(v[j].w)));
#pragma unroll
    for (int o = 1; o < 64; o <<= 1) m = fmaxf(m, __shfl_xor(m, o));
    m = fmaxf(m, 1e-20f); const float inv = 127.f / m;
#pragma unroll
    for (int j = 0; j < 4; ++j) *(GAS unsigned*)(dst + 4 * lane + 256 * j) = pk4_i8(v[j].x * inv, v[j].y * inv, v[j].z * inv, v[j].w * inv);
    if (lane == 0) hs[0] = m * (1.f / 127.f);
}
__device__ __forceinline__ void store_row_fp8(GAS unsigned char* dst, const f32x4 (&v)[4], int lane) {
#pragma unroll
    for (int j = 0; j < 4; ++j) *(GAS unsigned*)(dst + 4 * lane + 256 * j) = pk4_fp8(v[j].x, v[j].y, v[j].z, v[j].w);
}
constexpr int XIMG_P = 2064;
struct DtFrag { bf16x8 h[4], l[4]; };
__device__ __forceinline__ void dt_frags(const Ctx& c, int L, DtFrag& F) {
    const GAS float* win = gp(c.p->in[I_WIN]) + (size_t)L * 1024 * INW + 2048;
    const int fi = c.lane & 15, kg = c.lane >> 4;
#pragma unroll
    for (int s4 = 0; s4 < 4; ++s4) { const GAS float* wp = win + (size_t)(128 * c.wave + 32 * s4 + 8 * kg) * INW + fi; u32x4 h, l;
#pragma unroll
        for (int t = 0; t < 4; ++t) { const float x0 = wp[(size_t)(2 * t) * INW], x1 = wp[(size_t)(2 * t + 1) * INW]; const unsigned hh = pg8::cvt_pk_bf16(x0, x1); h[t] = hh; l[t] = pg8::cvt_pk_bf16(x0 - bflo(hh), x1 - bfhi(hh)); }
        F.h[s4] = __builtin_bit_cast(bf16x8, h); F.l[s4] = __builtin_bit_cast(bf16x8, l); }
}
__device__ __forceinline__ void ximg_write(const Ctx& c, int slot, const f32x4 (&v)[4]) {
    LAS unsigned char* XH = c.lds; LAS unsigned char* XL = c.lds + 16 * XIMG_P;
#pragma unroll
    for (int j = 0; j < 4; ++j) { u32x2 h, l; h.x = pg8::cvt_pk_bf16(v[j].x, v[j].y); h.y = pg8::cvt_pk_bf16(v[j].z, v[j].w);
        l.x = pg8::cvt_pk_bf16(v[j].x - bflo(h.x), v[j].y - bfhi(h.x)); l.y = pg8::cvt_pk_bf16(v[j].z - bflo(h.y), v[j].w - bfhi(h.y));
        *(LAS u32x2*)(XH + slot * XIMG_P + (4 * c.lane + 256 * j) * 2) = h; *(LAS u32x2*)(XL + slot * XIMG_P + (4 * c.lane + 256 * j) * 2) = l; }
}
__device__ __forceinline__ void dt_batch(const Ctx& c, const DtFrag& F, GAS float* DT, int bt, int st, int nr) {
    LAS unsigned char* XH = c.lds; LAS unsigned char* XL = c.lds + 16 * XIMG_P; LAS unsigned char* PART = c.lds + 32 * XIMG_P;
    const int fi = c.lane & 15, kg = c.lane >> 4;
    asm volatile("s_waitcnt lgkmcnt(0)" ::: "memory"); __builtin_amdgcn_s_barrier(); asm volatile("" ::: "memory");
    f32x4 d0 = {0.f, 0.f, 0.f, 0.f};
#pragma unroll
    for (int s4 = 0; s4 < 4; ++s4) { const int off = fi * XIMG_P + (128 * c.wave + 32 * s4 + 8 * kg) * 2;
        const bf16x8 xh = *(const LAS bf16x8*)(XH + off), xl = *(const LAS bf16x8*)(XL + off);
        d0 = __builtin_amdgcn_mfma_f32_16x16x32_bf16(F.h[s4], xh, d0, 0, 0, 0); d0 = __builtin_amdgcn_mfma_f32_16x16x32_bf16(F.h[s4], xl, d0, 0, 0, 0); d0 = __builtin_amdgcn_mfma_f32_16x16x32_bf16(F.l[s4], xh, d0, 0, 0, 0); }
    *(LAS f32x4*)(PART + c.wave * 1280 + fi * 80 + kg * 16) = d0;
    asm volatile("s_waitcnt lgkmcnt(0)" ::: "memory"); __builtin_amdgcn_s_barrier(); asm volatile("" ::: "memory");
    if (c.tid < 256) { const int sl = c.tid >> 4, e = c.tid & 15; float sm = 0.f;
#pragma unroll
        for (int q = 0; q < 8; ++q) sm += *(const LAS float*)(PART + q * 1280 + sl * 80 + e * 4);
        const int row = c.bid * 8 + (sl >> 1) + (2 * bt + (sl & 1)) * st;
        if (row < nr) DT[(size_t)row * 16 + e] = sm; }
}
__device__ __forceinline__ void ph_norm1_init(const Ctx& c, GAS unsigned char* ws) {
    const LAS Params& P = *c.p;
    DtFrag F; dt_frags(c, 0, F);
    __syncthreads();
    GAS float* DT = (GAS float*)(ws + OFF_DT);
    const int st = c.ngw, nr = NT;
    auto src_of = [&](int row) -> const GAS float* { return (row < NL) ? (gp(P.in[I_X]) + (size_t)row * 1024) : (gp(P.in[I_CTX]) + (size_t)(row - NL) * 1024); };
    f32x4 nx[4];
    if (c.gw < nr) { const GAS float* src = src_of(c.gw);
#pragma unroll
        for (int j = 0; j < 4; ++j) nx[j] = *(const GAS f32x4*)(src + 4 * c.lane + 256 * j); }
    const int nbatch = (((nr - c.bid * 8 - 1) / st + 1) + 1) / 2;
    ModVec MV; int mcur = -1;
    for (int k = 0; k < 2 * nbatch; ++k) {
        const int row = c.gw + k * st;
        if (row < nr) {
            f32x4 v[4];
#pragma unroll
            for (int j = 0; j < 4; ++j) v[j] = nx[j];
            { const int nrow = row + st; if (nrow < nr) { const GAS float* src = src_of(nrow);
#pragma unroll
                for (int j = 0; j < 4; ++j) nx[j] = *(const GAS f32x4*)(src + 4 * c.lane + 256 * j); } }
            if (mod_index(row) != mcur) { mcur = mod_index(row); const GAS float* md = mod_row(ws, 0, row); modvec_load(MV, gp(P.in[I_N1W]), md, md + 1024, c.lane); }
            norm_apply(v, MV);
            store_row_i8(ws + OFF_H8 + (size_t)row * 1024, (GAS float*)(ws + OFF_HS) + row, v, c.lane);
            ximg_write(c, 2 * c.wave + (k & 1), v);
        }
        if (k & 1) dt_batch(c, F, DT, k >> 1, st, nr);
    }
}

__device__ __forceinline__ void ph_norm2_router(const Ctx& c, GAS unsigned char* ws, int L, int nrows_lat_ctx) {
    const LAS Params& P = *c.p;
    constexpr int XP = 2064;
    LAS unsigned char* XH = c.lds; LAS unsigned char* XL = c.lds + 16 * XP;
    LAS unsigned char* PART = c.lds + 32 * XP;
    LAS float* SC = (LAS float*)(c.lds + 32 * XP + 8 * 2304);
    LAS unsigned* hist = (LAS unsigned*)(c.lds + 32 * XP + 8 * 2304 + 2304);
    const GAS float* wr = gp(P.in[I_WROUTER]);
    const int w = c.wave, lane = c.lane, fi = lane & 15, kg = lane >> 4;
    __syncthreads();
    if (c.tid < 32) hist[c.tid] = 0u;
    bf16x8 Wh[2][4], Wl[2][4];
#pragma unroll
    for (int hf = 0; hf < 2; ++hf)
#pragma unroll
        for (int s4 = 0; s4 < 4; ++s4) { const GAS float* wp = wr + (size_t)(128 * w + 32 * s4 + 8 * kg) * 32 + 16 * hf + fi; u32x4 h, l;
#pragma unroll
            for (int t = 0; t < 4; ++t) { const float x0 = wp[(2 * t) * 32], x1 = wp[(2 * t + 1) * 32]; const unsigned hh = pg8::cvt_pk_bf16(x0, x1); h[t] = hh; l[t] = pg8::cvt_pk_bf16(x0 - bflo(hh), x1 - bfhi(hh)); }
            Wh[hf][s4] = __builtin_bit_cast(bf16x8, h); Wl[hf][s4] = __builtin_bit_cast(bf16x8, l); }
    GAS int* tok_e = (GAS int*)(ws + OFF_TOKE); GAS float* tok_w = (GAS float*)(ws + OFF_TOKW); GAS int* rowtok = (GAS int*)(ws + OFF_ROWTOK);
    for (int i = c.bid * 512 + c.tid; i < MAXROWS; i += c.nblk * 512) rowtok[i] = NT;
    if (c.gw == 0) { for (int j = 0; j < 4; ++j) *(GAS unsigned*)(ws + OFF_H8 + (size_t)NT * 1024 + 4 * c.lane + 256 * j) = 0u; if (c.lane == 0) ((GAS float*)(ws + OFF_HS))[NT] = 0.f; }
    const GAS float* rbias = gp(P.in[I_RBIAS]);
    ModVec MV; int mcur = -1;
    auto prep_row = [&](int row, const u32x2 (&nx)[4], int slot) {
        f32x4 v[4];
#pragma unroll
        for (int j = 0; j < 4; ++j) v[j] = unpack4(nx[j]);
        if (mod_index(row) != mcur) { mcur = mod_index(row); const GAS float* md = mod_row(ws, L, row); modvec_load(MV, gp(P.in[I_N2W]) + L * 1024, md + 3 * 1024, md + 4 * 1024, c.lane); }
        norm_apply(v, MV);
        store_row_i8(ws + OFF_H8 + (size_t)row * 1024, (GAS float*)(ws + OFF_HS) + row, v, c.lane);
#pragma unroll
        for (int j = 0; j < 4; ++j) { u32x2 h, l; h.x = pg8::cvt_pk_bf16(v[j].x, v[j].y); h.y = pg8::cvt_pk_bf16(v[j].z, v[j].w);
            l.x = pg8::cvt_pk_bf16(v[j].x - bflo(h.x), v[j].y - bfhi(h.x)); l.y = pg8::cvt_pk_bf16(v[j].z - bflo(h.y), v[j].w - bfhi(h.y));
            *(LAS u32x2*)(XH + slot * XP + (4 * c.lane + 256 * j) * 2) = h; *(LAS u32x2*)(XL + slot * XP + (4 * c.lane + 256 * j) * 2) = l; } };
    auto zero_row = [&](int slot) {
#pragma unroll
        for (int j = 0; j < 4; ++j) { *(LAS u32x2*)(XH + slot * XP + (4 * c.lane + 256 * j) * 2) = (u32x2){0u, 0u}; *(LAS u32x2*)(XL + slot * XP + (4 * c.lane + 256 * j) * 2) = (u32x2){0u, 0u}; } };
    auto finish_row = [&](int slot, int row) {
        float sc[32];
#pragma unroll
        for (int q = 0; q < 8; ++q) { const f32x4 t = *(const LAS f32x4*)(SC + slot * 36 + 4 * q); sc[4 * q] = t.x; sc[4 * q + 1] = t.y; sc[4 * q + 2] = t.z; sc[4 * q + 3] = t.w; }
        float bestg = -1e30f; int bg = 0; float s0 = 0.f, s1 = 0.f, s2 = 0.f, s3 = 0.f, b0 = 0.f, b1 = 0.f, b2 = 0.f, b3 = 0.f;
#pragma unroll
        for (int g = 0; g < 8; ++g) {
            const float e0 = sc[4 * g] + rbias[4 * g], e1 = sc[4 * g + 1] + rbias[4 * g + 1], e2 = sc[4 * g + 2] + rbias[4 * g + 2], e3 = sc[4 * g + 3] + rbias[4 * g + 3];
            const float hi = fmaxf(e0, e1), lo = fminf(e0, e1), hi2 = fmaxf(e2, e3), lo2 = fminf(e2, e3);
            const float gs = fmaxf(hi, hi2) + fmaxf(fminf(hi, hi2), fmaxf(lo, lo2));
            if (gs > bestg) { bestg = gs; bg = g; s0 = e0; s1 = e1; s2 = e2; s3 = e3; b0 = sc[4 * g]; b1 = sc[4 * g + 1]; b2 = sc[4 * g + 2]; b3 = sc[4 * g + 3]; }
        }
        int i1 = 0; float m1 = s0; if (s1 > m1) { m1 = s1; i1 = 1; } if (s2 > m1) { m1 = s2; i1 = 2; } if (s3 > m1) { m1 = s3; i1 = 3; }
        int i2 = -1; float m2 = -1e30f;
        if (i1 != 0 && s0 > m2) { m2 = s0; i2 = 0; } if (i1 != 1 && s1 > m2) { m2 = s1; i2 = 1; } if (i1 != 2 && s2 > m2) { m2 = s2; i2 = 2; } if (i1 != 3 && s3 > m2) { m2 = s3; i2 = 3; }
        const float w1 = (i1 == 0) ? b0 : (i1 == 1) ? b1 : (i1 == 2) ? b2 : b3;
        const float w2 = (i2 == 0) ? b0 : (i2 == 1) ? b1 : (i2 == 2) ? b2 : b3;
        const float inv = 1.f / (w1 + w2);
        { const int ea = bg * 4 + i1, eb = bg * 4 + i2; tok_e[row * 2] = ea; tok_e[row * 2 + 1] = eb; tok_w[row * 2] = w1 * inv; tok_w[row * 2 + 1] = w2 * inv;
            __hip_atomic_fetch_add(&hist[ea], 1u, __ATOMIC_RELAXED, __HIP_MEMORY_SCOPE_WORKGROUP); __hip_atomic_fetch_add(&hist[eb], 1u, __ATOMIC_RELAXED, __HIP_MEMORY_SCOPE_WORKGROUP); } };
    const int st = c.ngw, nr = nrows_lat_ctx;
    u32x2 nxA[4] = {}, nxB[4] = {};
    if (c.gw < nr) load_xr(ws, c.gw, c.lane, nxA);
    if (c.gw + st < nr) load_xr(ws, c.gw + st, c.lane, nxB);
    const int nbatch = (((nr - c.bid * 8 - 1) / st + 1) + 1) / 2;
    for (int bt = 0; bt < nbatch; ++bt) {
        const int rowA = c.gw + (2 * bt) * st, rowB = rowA + st;
        if (rowA < nr) prep_row(rowA, nxA, 2 * w); else zero_row(2 * w);
        if (rowB < nr) prep_row(rowB, nxB, 2 * w + 1); else zero_row(2 * w + 1);
        if (rowA + 2 * st < nr) load_xr(ws, rowA + 2 * st, c.lane, nxA);
        if (rowB + 2 * st < nr) load_xr(ws, rowB + 2 * st, c.lane, nxB);
        asm volatile("s_waitcnt lgkmcnt(0)" ::: "memory"); __builtin_amdgcn_s_barrier(); asm volatile("" ::: "memory");
        f32x4 d0 = {0.f, 0.f, 0.f, 0.f}, d1 = {0.f, 0.f, 0.f, 0.f};
#pragma unroll
        for (int s4 = 0; s4 < 4; ++s4) { const int off = fi * XP + (128 * w + 32 * s4 + 8 * kg) * 2;
            const bf16x8 xh = *(const LAS bf16x8*)(XH + off), xl = *(const LAS bf16x8*)(XL + off);
            d0 = __builtin_amdgcn_mfma_f32_16x16x32_bf16(Wh[0][s4], xh, d0, 0, 0, 0); d0 = __builtin_amdgcn_mfma_f32_16x16x32_bf16(Wh[0][s4], xl, d0, 0, 0, 0); d0 = __builtin_amdgcn_mfma_f32_16x16x32_bf16(Wl[0][s4], xh, d0, 0, 0, 0);
            d1 = __builtin_amdgcn_mfma_f32_16x16x32_bf16(Wh[1][s4], xh, d1, 0, 0, 0); d1 = __builtin_amdgcn_mfma_f32_16x16x32_bf16(Wh[1][s4], xl, d1, 0, 0, 0); d1 = __builtin_amdgcn_mfma_f32_16x16x32_bf16(Wl[1][s4], xh, d1, 0, 0, 0); }
        *(LAS f32x4*)(PART + w * 2304 + fi * 144 + (4 * kg) * 4) = d0; *(LAS f32x4*)(PART + w * 2304 + fi * 144 + (16 + 4 * kg) * 4) = d1;
        asm volatile("s_waitcnt lgkmcnt(0)" ::: "memory"); __builtin_amdgcn_s_barrier(); asm volatile("" ::: "memory");
        { const int sl = c.tid >> 5, e = c.tid & 31; float sm = 0.f;
#pragma unroll
          for (int q = 0; q < 8; ++q) sm += *(const LAS float*)(PART + q * 2304 + sl * 144 + e * 4);
          SC[sl * 36 + e] = sigmoid_f(sm); }
        asm volatile("s_waitcnt lgkmcnt(0)" ::: "memory"); __builtin_amdgcn_s_barrier(); asm volatile("" ::: "memory");
        if (w == (bt & 7) && lane < 16) { const int row = c.bid * 8 + (lane >> 1) + (2 * bt + (lane & 1)) * st; if (row < nr) finish_row(lane, row); }
    }
    __syncthreads();
    GAS unsigned* ctl = (GAS unsigned*)(ws + OFF_CTL);
    if (c.tid < 32) { const unsigned hv = hist[c.tid]; if (hv) __hip_atomic_fetch_add(&ctl[CW_CNT + L * 32 + c.tid], hv, __ATOMIC_RELAXED, __HIP_MEMORY_SCOPE_AGENT); }
}

__device__ __forceinline__ void ph_dispatch(const Ctx& c, GAS unsigned char* ws, int L, int nrows) {
    GAS unsigned* ctl = (GAS unsigned*)(ws + OFF_CTL);
    LAS int* pstart = (LAS int*)c.lds;
    LAS unsigned* lcnt = (LAS unsigned*)(c.lds + 256);
    LAS unsigned* lbase = (LAS unsigned*)(c.lds + 512);
    if (c.tid < 32) { lcnt[c.tid] = 0u; lbase[c.tid] = __hip_atomic_load(&ctl[CW_CNT + L * 32 + c.tid], __ATOMIC_RELAXED, __HIP_MEMORY_SCOPE_AGENT); }
    __syncthreads();
    if (c.tid == 0) { int s = 0; for (int e = 0; e < 32; ++e) { pstart[e] = s; s += ((int)lbase[e] + 255) & ~255; } pstart[32] = s; }
    __syncthreads();
    const GAS int* tok_e = (const GAS int*)(ws + OFF_TOKE); GAS int* pos_of = (GAS int*)(ws + OFF_POSOF); GAS int* rowtok = (GAS int*)(ws + OFF_ROWTOK); GAS int* tile_e = (GAS int*)(ws + OFF_TILEE);
    const int na = nrows * 2; const int per = (na + c.nblk - 1) / c.nblk; const int a0 = c.bid * per, a1 = min(na, a0 + per);
    int myr[2] = {0, 0}, mye[2] = {0, 0};
#pragma unroll
    for (int k = 0; k < 2; ++k) { const int a = a0 + c.tid + 512 * k; if (a < a1) { mye[k] = tok_e[a]; myr[k] = (int)__hip_atomic_fetch_add(&lcnt[mye[k]], 1u, __ATOMIC_RELAXED, __HIP_MEMORY_SCOPE_WORKGROUP); } }
    __syncthreads();
    if (c.tid < 32) { const unsigned n = lcnt[c.tid]; lbase[c.tid] = n ? __hip_atomic_fetch_add(&ctl[CW_CUR + L * 32 + c.tid], n, __ATOMIC_RELAXED, __HIP_MEMORY_SCOPE_AGENT) : 0u; }
    __syncthreads();
#pragma unroll
    for (int k = 0; k < 2; ++k) { const int a = a0 + c.tid + 512 * k; if (a < a1) { const int pos = pstart[mye[k]] + (int)lbase[mye[k]] + myr[k]; pos_of[a] = pos; rowtok[pos] = a >> 1; } }
    if (c.bid == 0) { const int ntile = pstart[32] >> 8;
        for (int t = c.tid; t < ntile; t += 512) { int e = 0; for (int q = 1; q < 32; ++q) if ((t << 8) >= pstart[q]) e = q; tile_e[t] = e; }
        if (c.tid == 0) ctl[CW_NT + L] = (unsigned)ntile;
        if (c.tid < 8) { GAS int* xi = tile_e + 512 + c.tid * 16; int acc = 0; xi[0] = 0;
            for (int q = 0; q < 4; ++q) { const int e = c.tid + 8 * q; xi[8 + q] = pstart[e] >> 8; acc += (pstart[e + 1] - pstart[e]) >> 8; xi[1 + q] = acc; } } }
}

__device__ __forceinline__ void ph_combine(const Ctx& c, GAS unsigned char* ws, int L, int nrows) {
    const LAS Params& P = *c.p;
    const bool last = (L == DEPTH - 1);
    DtFrag F; if (!last) dt_frags(c, L + 1, F);
    __syncthreads();
    GAS bf16_t* H = (GAS bf16_t*)(ws + OFF_H); GAS float* DT = (GAS float*)(ws + OFF_DT);
    const GAS bf16_t* YB = (const GAS bf16_t*)(ws + OFF_MYB); const GAS int* pos_of = (const GAS int*)(ws + OFF_POSOF); const GAS float* tok_w = (const GAS float*)(ws + OFF_TOKW);
    u32x2 nx[4], nya[4], nyb[4]; float nw0 = 0.f, nw1 = 0.f;
    int fp0 = 0, fp1 = 0; float fw0 = 0.f, fw1 = 0.f;
    auto fetch_info = [&](int row) { fp0 = pos_of[row * 2]; fp1 = pos_of[row * 2 + 1]; fw0 = tok_w[row * 2]; fw1 = tok_w[row * 2 + 1]; };
    auto fetch = [&](int row) { const int p0 = fp0, p1 = fp1; nw0 = fw0; nw1 = fw1; load_xr(ws, row, c.lane, nx);
#pragma unroll
        for (int j = 0; j < 4; ++j) { const int idx = 4 * c.lane + 256 * j; nya[j] = *(const GAS u32x2*)(YB + (size_t)p0 * 1024 + idx); nyb[j] = *(const GAS u32x2*)(YB + (size_t)p1 * 1024 + idx); } };
    if (c.gw < nrows) { fetch_info(c.gw); fetch(c.gw); if (c.gw + c.ngw < nrows) fetch_info(c.gw + c.ngw); }
    const int nbatch = (((nrows - c.bid * 8 - 1) / c.ngw + 1) + 1) / 2;
    ModVec MV; int mcur = -1; f32x4 GV[4]; int gcur = -1;
    for (int k = 0; k < 2 * nbatch; ++k) { const int row = c.gw + k * c.ngw;
      if (row < nrows) {
        if (mod_index(row) != gcur) { gcur = mod_index(row); const GAS float* md = mod_row(ws, L, row) + 5 * 1024;
#pragma unroll
            for (int j = 0; j < 4; ++j) GV[j] = *(const GAS f32x4*)(md + 4 * c.lane + 256 * j); }
        f32x4 v[4]; u32x2 ya[4], yb[4]; const float w0 = nw0, w1 = nw1;
#pragma unroll
        for (int j = 0; j < 4; ++j) { v[j] = unpack4(nx[j]); ya[j] = nya[j]; yb[j] = nyb[j]; }
        if (row + c.ngw < nrows) { fetch(row + c.ngw); if (row + 2 * c.ngw < nrows) fetch_info(row + 2 * c.ngw); }
#pragma unroll
        for (int j = 0; j < 4; ++j) { const f32x4 g = GV[j];
            f32x4 f; f.x = w0 * bflo(ya[j].x) + w1 * bflo(yb[j].x); f.y = w0 * bfhi(ya[j].x) + w1 * bfhi(yb[j].x); f.z = w0 * bflo(ya[j].y) + w1 * bflo(yb[j].y); f.w = w0 * bfhi(ya[j].y) + w1 * bfhi(yb[j].y);
            v[j] = v[j] + g * f; }
        if (!last) {
            store_row_bf16((GAS bf16_t*)(ws + OFF_XR) + (size_t)row * 1024, v, c.lane);
            if (mod_index(row) != mcur) { mcur = mod_index(row); const GAS float* m2 = mod_row(ws, L + 1, row); modvec_load(MV, gp(P.in[I_N1W]) + (L + 1) * 1024, m2, m2 + 1024, c.lane); }
            norm_apply(v, MV);
            store_row_i8(ws + OFF_H8 + (size_t)row * 1024, (GAS float*)(ws + OFF_HS) + row, v, c.lane);
            ximg_write(c, 2 * c.wave + (k & 1), v);
        } else {
            if (mcur < 0) { mcur = 0; modvec_load(MV, gp(P.in[I_FNW]), nullptr, nullptr, c.lane); }
            norm_apply(v, MV);
            GAS float* xo = gp(P.out) + (size_t)row * 1024;
#pragma unroll
            for (int j = 0; j < 4; ++j) *(GAS f32x4*)(xo + 4 * c.lane + 256 * j) = v[j];
        }
      }
      if (!last && (k & 1)) dt_batch(c, F, DT, k >> 1, c.ngw, nrows);
    }
}

__device__ __forceinline__ void seq_of(int row, int& base, int& pos, int& len) {
    if (row < NL) { base = row & ~(SEQ - 1); pos = row & (SEQ - 1); len = SEQ; } else { const int r = row - NL; base = NL + (r & ~(LC - 1)); pos = r & (LC - 1); len = LC; }
}

__device__ __forceinline__ void ph_shortconv(const Ctx& c, GAS unsigned char* ws, int L, int nrows) {
    const GAS float* w = gp(c.p->in[I_SCW]) + (size_t)L * 3 * 512;
    const GAS bf16_t* PX = (const GAS bf16_t*)(ws + OFF_PX); GAS bf16_t* BR = (GAS bf16_t*)(ws + OFF_BR);
    float wr[3][8];
    { const int cw0 = (c.tid & 63) * 8;
#pragma unroll
      for (int t = 0; t < 3; ++t) { const f32x4 a = *(const GAS f32x4*)(w + t * 512 + cw0), b = *(const GAS f32x4*)(w + t * 512 + cw0 + 4); wr[t][0] = a.x; wr[t][1] = a.y; wr[t][2] = a.z; wr[t][3] = a.w; wr[t][4] = b.x; wr[t][5] = b.y; wr[t][6] = b.z; wr[t][7] = b.w; } }
    for (int it = c.bid * 512 + c.tid; it < nrows * 64; it += c.nblk * 512) {
        const int row = it >> 6, c0 = (it & 63) * 8; int base, pos, len; seq_of(row, base, pos, len);
        const GAS bf16_t* pr = PX + (size_t)row * 2048;
        const u32x4 bgv = *(const GAS u32x4*)(pr + 512 + c0);
        float acc[8];
#pragma unroll
        for (int e = 0; e < 8; ++e) acc[e] = 0.f;
#pragma unroll
        for (int t = 0; t < 3; ++t) { const int pp = pos + t - 1; if (pp < 0 || pp >= len) continue;
            const GAS bf16_t* qr = PX + (size_t)(base + pp) * 2048; const u32x4 cg = *(const GAS u32x4*)(qr + 1024 + c0), xs = *(const GAS u32x4*)(qr + 1536 + c0);
#pragma unroll
            for (int h = 0; h < 4; ++h) { acc[2 * h] += wr[t][2 * h] * (bflo(cg[h]) * bflo(xs[h])); acc[2 * h + 1] += wr[t][2 * h + 1] * (bfhi(cg[h]) * bfhi(xs[h])); } }
        u32x4 o;
#pragma unroll
        for (int h = 0; h < 4; ++h) o[h] = pk2(bflo(bgv[h]) * acc[2 * h], bfhi(bgv[h]) * acc[2 * h + 1]);
        *(GAS u32x4*)(BR + (size_t)row * 2048 + 1536 + c0) = o;
    }
}

__device__ __forceinline__ void ph_chandft(const Ctx& c, GAS unsigned char* ws, int row_lo, int nrows) {
    const GAS f32x2* tw = (const GAS f32x2*)(ws + OFF_TW);
    LAS f32x2* t64 = (LAS f32x2*)c.lds;
    if (c.tid < 64) t64[c.tid] = tw[128 * c.tid];
    __syncthreads();
    const GAS bf16_t* PX = (const GAS bf16_t*)(ws + OFF_PX); GAS bf16_t* V = (GAS bf16_t*)(ws + OFF_V);
    for (int it = row_lo * 8 + c.gw; it < nrows * 8; it += c.ngw) {
        const int row = it >> 3, g = it & 7; const GAS bf16_t* u = PX + (size_t)row * 2048 + g * 64;
        float re = 0.f, im = 0.f;
#pragma unroll 8
        for (int cc = 0; cc < 64; cc += 2) { const unsigned uu = *(const GAS unsigned*)(u + cc);
            const f32x2 t0 = t64[(c.lane * cc) & 63], t1 = t64[(c.lane * (cc + 1)) & 63];
            const float u0 = bflo(uu), u1 = bfhi(uu);
            re += u0 * t0.x + u1 * t1.x; im -= u0 * t0.y + u1 * t1.y; }
        V[(size_t)row * 1024 + g * 128 + c.lane] = (bf16_t)f2bf(re * 0.125f); V[(size_t)row * 1024 + g * 128 + 64 + c.lane] = (bf16_t)f2bf(im * 0.125f);
    }
}
typedef float f32x16 __attribute__((ext_vector_type(16)));
typedef short s16x4 __attribute__((ext_vector_type(4)));
__device__ __forceinline__ s16x4 lds_tr16(LAS unsigned char* p) { return __builtin_amdgcn_ds_read_tr16_b64_v4i16((LAS s16x4*)p); }
__device__ __forceinline__ unsigned cvtpk(float lo, float hi) { return pg8::cvt_pk_bf16(lo, hi); }
__device__ __forceinline__ int crow16(int r, int hi) { return (r & 3) + 8 * (r >> 2) + 4 * hi; }
__device__ __forceinline__ void attn_mfma_unit(const Ctx& c, GAS unsigned char* ws, int L, int un) {
    const LAS Params& P = *c.p;
    const GAS bf16_t* PX = (const GAS bf16_t*)(ws + OFF_PX); GAS bf16_t* BR = (GAS bf16_t*)(ws + OFF_BR);
    const bool isctx = un >= 1024; int b, kvh, qb;
    if (!isctx) { b = un >> 8; kvh = (un >> 7) & 1; qb = un & 127; } else { const int u2 = un - 1024; b = u2 >> 3; kvh = (u2 >> 2) & 1; qb = u2 & 3; }
    const int lane = c.lane, r32 = lane & 31, hi = lane >> 5, w = c.wave, g = w >> 1, qs = w & 1, head = kvh * 4 + g;
    const int qi = qs * 32 + r32;
    const int qrow = (isctx ? (NL + b * LC) : (b * SEQ)) + qb * 64 + qi;
    bf16x8 qf[4];
#pragma unroll
    for (int s = 0; s < 4; ++s) qf[s] = *(const GAS bf16x8*)(PX + (size_t)qrow * 2048 + head * 64 + 16 * s + 8 * hi);
    int tlo = 0, nloc = 0;
    if (!isctx) { tlo = max(0, 2 - qb); const int thi = min(4, 129 - qb); nloc = thi - tlo + 1; }
    const int ntile = nloc + 4;
    LAS unsigned char* KB = c.lds; LAS unsigned char* VB = c.lds + 8192;
    const int koff = r32 * 128;
    const int voff = (4 * hi + ((lane & 15) >> 2)) * 128 + (16 * ((lane >> 4) & 1) + 4 * (lane & 3)) * 2;
    auto tile_row0 = [&](int ti) -> int { return (ti < nloc) ? (b * SEQ + qb * 64 - 128 + 64 * (tlo + ti)) : (NL + b * LC + 64 * (ti - nloc)); };
    const int dk = lane >> 3, dc = lane & 7;
    const int ksrc = (8 * w + dk) * 2048 + kvh * 64 + ((dc ^ dk) * 8) + 512, vsrc = (8 * w + dk) * 2048 + kvh * 64 + dc * 8 + 640;
    auto dma_tile = [&](int ti) { const GAS bf16_t* base = PX + (size_t)tile_row0(ti) * 2048; LAS unsigned char* d = c.lds + (ti & 3) * 16384 + w * 1024;
        __builtin_amdgcn_global_load_lds((const GAS unsigned*)(base + ksrc), (LAS unsigned*)d, 16, 0, 0);
        __builtin_amdgcn_global_load_lds((const GAS unsigned*)(base + vsrc), (LAS unsigned*)(d + 8192), 16, 0, 0); };
    __syncthreads();
    dma_tile(0); dma_tile(1); dma_tile(2);
    asm volatile("" :: "v"(qf[0]), "v"(qf[1]), "v"(qf[2]), "v"(qf[3]));
    f32x16 o0 = {}, o1 = {};
    float m_raw = -1e30f, lsum = 0.f;
    const float c2 = 0.125f * 1.4426950408889634f;
    for (int ti = 0; ti < ntile; ++ti) {
        const int buf = (ti & 3) * 16384;
        if (ti + 2 < ntile) asm volatile("s_waitcnt vmcnt(4)" ::: "memory"); else if (ti + 1 < ntile) asm volatile("s_waitcnt vmcnt(2)" ::: "memory"); else asm volatile("s_waitcnt vmcnt(0)" ::: "memory");
        __builtin_amdgcn_s_barrier(); asm volatile("" ::: "memory");
        if (ti + 3 < ntile) dma_tile(ti + 3);
        f32x16 p0 = {}, p1 = {};
        { bf16x8 kf0[4], kf1[4];
#pragma unroll
          for (int s = 0; s < 4; ++s) { const int ch = ((2 * s + hi) ^ (r32 & 7)) * 16; kf0[s] = *(const LAS bf16x8*)(KB + buf + koff + ch); kf1[s] = *(const LAS bf16x8*)(KB + buf + 4096 + koff + ch); }
          asm volatile("" : "+v"(kf0[0]), "+v"(kf0[1]), "+v"(kf0[2]), "+v"(kf0[3]), "+v"(kf1[0]), "+v"(kf1[1]), "+v"(kf1[2]), "+v"(kf1[3]));
#pragma unroll
          for (int s = 0; s < 4; ++s) { p0 = __builtin_amdgcn_mfma_f32_32x32x16_bf16(kf0[s], qf[s], p0, 0, 0, 0); p1 = __builtin_amdgcn_mfma_f32_32x32x16_bf16(kf1[s], qf[s], p1, 0, 0, 0); } }
        const int t = (ti < nloc) ? (tlo + ti) : 2;
        if (t == 0) {
#pragma unroll
            for (int r = 0; r < 16; ++r) { const int j = crow16(r, hi); if (j < qi) p0[r] = -1e30f; if (j + 32 < qi) p1[r] = -1e30f; }
        } else if (t == 4) {
#pragma unroll
            for (int r = 0; r < 16; ++r) { const int j = crow16(r, hi); if (j > qi) p0[r] = -1e30f; if (j + 32 > qi) p1[r] = -1e30f; }
        }
        float mx = p0[0];
#pragma unroll
        for (int r = 1; r < 16; ++r) mx = fmaxf(mx, p0[r]);
#pragma unroll
        for (int r = 0; r < 16; ++r) mx = fmaxf(mx, p1[r]);
        mx = fmaxf(mx, __shfl_xor(mx, 32));
        const float mn = fmaxf(m_raw, mx); const float alpha = __builtin_amdgcn_exp2f((m_raw - mn) * c2); m_raw = mn;
        const float nb = -mn * c2; float ps = 0.f;
#pragma unroll
        for (int r = 0; r < 16; ++r) { p0[r] = __builtin_amdgcn_exp2f(p0[r] * c2 + nb); p1[r] = __builtin_amdgcn_exp2f(p1[r] * c2 + nb); ps += p0[r] + p1[r]; }
        lsum = lsum * alpha + ps;
        if (!__all(alpha == 1.f)) {
#pragma unroll
            for (int r = 0; r < 16; ++r) { o0[r] *= alpha; o1[r] *= alpha; } }
        u32x4 pw[4];
#pragma unroll
        for (int q = 0; q < 4; ++q) { pw[0][q] = cvtpk(p0[2 * q], p0[2 * q + 1]); pw[1][q] = cvtpk(p0[8 + 2 * q], p0[8 + 2 * q + 1]); pw[2][q] = cvtpk(p1[2 * q], p1[2 * q + 1]); pw[3][q] = cvtpk(p1[8 + 2 * q], p1[8 + 2 * q + 1]); }
        {
          const unsigned va = (unsigned)(size_t)(VB + buf + voff);
          s16x4 a0[4], a1[4], b0[4], b1[4];
#pragma unroll
          for (int s = 0; s < 4; ++s)
              asm volatile("ds_read_b64_tr_b16 %0, %4 offset:%5\n\tds_read_b64_tr_b16 %1, %4 offset:%6\n\tds_read_b64_tr_b16 %2, %4 offset:%7\n\tds_read_b64_tr_b16 %3, %4 offset:%8"
                           : "=&v"(a0[s]), "=&v"(a1[s]), "=&v"(b0[s]), "=&v"(b1[s]) : "v"(va), "n"(s * 2048), "n"(s * 2048 + 1024), "n"(s * 2048 + 64), "n"(s * 2048 + 1088));
#pragma unroll
          for (int s = 0; s < 4; ++s) {
              if (s == 0) asm volatile("s_waitcnt lgkmcnt(12)" : "+v"(a0[0]), "+v"(a1[0]), "+v"(b0[0]), "+v"(b1[0]));
              else if (s == 1) asm volatile("s_waitcnt lgkmcnt(8)" : "+v"(a0[1]), "+v"(a1[1]), "+v"(b0[1]), "+v"(b1[1]));
              else if (s == 2) asm volatile("s_waitcnt lgkmcnt(4)" : "+v"(a0[2]), "+v"(a1[2]), "+v"(b0[2]), "+v"(b1[2]));
              else asm volatile("s_waitcnt lgkmcnt(0)" : "+v"(a0[3]), "+v"(a1[3]), "+v"(b0[3]), "+v"(b1[3]));
              const bf16x8 v0 = (bf16x8){a0[s][0], a0[s][1], a0[s][2], a0[s][3], a1[s][0], a1[s][1], a1[s][2], a1[s][3]}, v1 = (bf16x8){b0[s][0], b0[s][1], b0[s][2], b0[s][3], b1[s][0], b1[s][1], b1[s][2], b1[s][3]};
              const bf16x8 pb = __builtin_bit_cast(bf16x8, pw[s]);
              o0 = __builtin_amdgcn_mfma_f32_32x32x16_bf16(v0, pb, o0, 0, 0, 0);
              o1 = __builtin_amdgcn_mfma_f32_32x32x16_bf16(v1, pb, o1, 0, 0, 0); } }
    }
    { const float sk = gp(P.in[I_SINK])[L * 8 + head] * 8.f; const float mn = fmaxf(m_raw, sk); const float alpha = __builtin_amdgcn_exp2f((m_raw - mn) * c2);
      lsum = lsum * alpha; lsum += __shfl_xor(lsum, 32); lsum += __builtin_amdgcn_exp2f((sk - mn) * c2);
      const float inv = alpha / lsum;
      GAS bf16_t* op = BR + (size_t)qrow * 2048 + head * 64 + 4 * hi;
#pragma unroll
      for (int g4 = 0; g4 < 4; ++g4) { u32x2 w0, w1; w0.x = cvtpk(o0[4 * g4] * inv, o0[4 * g4 + 1] * inv); w0.y = cvtpk(o0[4 * g4 + 2] * inv, o0[4 * g4 + 3] * inv);
          w1.x = cvtpk(o1[4 * g4] * inv, o1[4 * g4 + 1] * inv); w1.y = cvtpk(o1[4 * g4 + 2] * inv, o1[4 * g4 + 3] * inv);
          *(GAS u32x2*)(op + 8 * g4) = w0; *(GAS u32x2*)(op + 32 + 8 * g4) = w1; } }
}

__device__ __forceinline__ void fft1_setup(const Ctx& c, GAS unsigned char* ws) {
    const GAS bf16_t* f128 = (const GAS bf16_t*)(ws + OFF_F128);
    __syncthreads();
    for (int i = c.tid; i < 2 * 128 * 16; i += 512) { const int tb = i >> 11, row = (i >> 4) & 127, ch = i & 15;
        const u32x4 v = *(const GAS u32x4*)(f128 + tb * 16384 + row * 128 + ch * 8);
        LAS unsigned char* d = c.lds + tb * 33792 + row * 264 + ch * 16;
        *(LAS u32x2*)d = (u32x2){v.x, v.y}; *(LAS u32x2*)(d + 8) = (u32x2){v.z, v.w}; }
    __syncthreads();
}
__device__ __forceinline__ bf16x8 f128_frag(const LAS unsigned char* tab, int k1, int ks, int hi) {
    const u32x2 a = *(const LAS u32x2*)(tab + k1 * 264 + (16 * ks + 4 * hi) * 2), b = *(const LAS u32x2*)(tab + k1 * 264 + (16 * ks + 8 + 4 * hi) * 2);
    return __builtin_bit_cast(bf16x8, (u32x4){a.x, a.y, b.x, b.y});
}
__device__ __forceinline__ void fft1_unit(const Ctx& c, GAS unsigned char* ws, int un) {
    const GAS bf16_t* PX = (const GAS bf16_t*)(ws + OFF_PX); GAS bf16_t* T = (GAS bf16_t*)(ws + OFF_T);
    const GAS bf16_t* f64 = (const GAS bf16_t*)(ws + OFF_F64); const GAS f32x2* tw = (const GAS f32x2*)(ws + OFF_TW);
    const int b = un >> 6, l2 = un & 63;
    const int w = c.wave, kb = w & 3, mb = w >> 2, lane = c.lane, r32 = lane & 31, hi = lane >> 5;
    const LAS unsigned char* COS = c.lds; const LAS unsigned char* SIN = c.lds + 33792;
    LAS f32x2* twl = (LAS f32x2*)(c.lds + 67584);
    __syncthreads();
    if (c.tid < 128) twl[c.tid] = tw[c.tid * l2];
    __syncthreads();
    bf16x8 fc[4], fs[4];
#pragma unroll
    for (int s = 0; s < 4; ++s) { fc[s] = *(const GAS bf16x8*)(f64 + (32 * mb + r32) * 64 + 16 * s + 8 * hi); fs[s] = *(const GAS bf16x8*)(f64 + 4096 + (32 * mb + r32) * 64 + 16 * s + 8 * hi); }
    const int k1l = 32 * kb + r32;
    LAS unsigned char* UT = c.lds + 69632;
    const int urow = 16 * w + (lane >> 3), uchk = (lane & 7) ^ (lane >> 3);
    const GAS bf16_t* usrc = PX + (size_t)(b * SEQ + 64 * urow + l2) * 2048 + uchk * 8;
    LAS unsigned char* udst = UT + w * 2048;
    __builtin_amdgcn_global_load_lds((const GAS unsigned*)usrc, (LAS unsigned*)udst, 16, 0, 0);
    __builtin_amdgcn_global_load_lds((const GAS unsigned*)(usrc + (size_t)512 * 2048), (LAS unsigned*)(udst + 1024), 16, 0, 0);
    asm volatile("s_waitcnt vmcnt(0)" ::: "memory");
    __syncthreads();
    for (int g = 0; g < 8; ++g) {
        const LAS unsigned char* UB = UT + (g & 1) * 16384;
        if (g + 1 < 8) { LAS unsigned char* un_ = udst + ((g + 1) & 1) * 16384;
            __builtin_amdgcn_global_load_lds((const GAS unsigned*)(usrc + (g + 1) * 64), (LAS unsigned*)un_, 16, 0, 0);
            __builtin_amdgcn_global_load_lds((const GAS unsigned*)(usrc + (size_t)512 * 2048 + (g + 1) * 64), (LAS unsigned*)(un_ + 1024), 16, 0, 0); }
        u32x4 vre[8], vq[8];
#pragma unroll
        for (int lb = 0; lb < 4; ++lb) {
            const int row = 32 * lb + r32;
            f32x16 xr = {}, xq = {};
#pragma unroll
            for (int s = 0; s < 4; ++s) { const bf16x8 u = *(const LAS bf16x8*)(UB + row * 128 + (((2 * s + hi) ^ (row & 7)) * 16)); xr = __builtin_amdgcn_mfma_f32_32x32x16_bf16(u, fc[s], xr, 0, 0, 0); xq = __builtin_amdgcn_mfma_f32_32x32x16_bf16(u, fs[s], xq, 0, 0, 0); }
#pragma unroll
            for (int q = 0; q < 4; ++q) { vre[2 * lb][q] = cvtpk(xr[2 * q], xr[2 * q + 1]); vre[2 * lb + 1][q] = cvtpk(xr[8 + 2 * q], xr[8 + 2 * q + 1]);
                vq[2 * lb][q] = cvtpk(xq[2 * q], xq[2 * q + 1]); vq[2 * lb + 1][q] = cvtpk(xq[8 + 2 * q], xq[8 + 2 * q + 1]); }
        }
        asm volatile("s_waitcnt vmcnt(0)" ::: "memory");
        __syncthreads();
        f32x16 a1 = {}, a2 = {}, pm = {};
#pragma unroll
        for (int ks = 0; ks < 8; ++ks) { const bf16x8 cf = f128_frag(COS, k1l, ks, hi), sf = f128_frag(SIN, k1l, ks, hi);
            const bf16x8 br = __builtin_bit_cast(bf16x8, vre[ks]), bq = __builtin_bit_cast(bf16x8, vq[ks]);
            a1 = __builtin_amdgcn_mfma_f32_32x32x16_bf16(cf, br, a1, 0, 0, 0); a2 = __builtin_amdgcn_mfma_f32_32x32x16_bf16(sf, bq, a2, 0, 0, 0);
            pm = __builtin_amdgcn_mfma_f32_32x32x16_bf16(sf, br, pm, 0, 0, 0); pm = __builtin_amdgcn_mfma_f32_32x32x16_bf16(cf, bq, pm, 0, 0, 0); }
        GAS bf16_t* tp = T + (size_t)(b * SEQ + l2) * 1024 + g * 128 + 32 * mb + r32;
#pragma unroll
        for (int r = 0; r < 16; ++r) { const int k1 = 32 * kb + crow16(r, hi); const f32x2 wv = twl[k1];
            const float tr = (a1[r] - a2[r]) * 0.011048543456039806f, pp = pm[r] * 0.011048543456039806f;
            GAS bf16_t* o = tp + (size_t)k1 * 64 * 1024;
            o[0] = (bf16_t)f2bf(tr * wv.x - pp * wv.y); o[64] = (bf16_t)f2bf(tr * wv.y + pp * wv.x); }
    }
}
__device__ __forceinline__ void fft2_unit(const Ctx& c, GAS unsigned char* ws, int un) {
    const GAS bf16_t* T = (const GAS bf16_t*)(ws + OFF_T); GAS bf16_t* BR = (GAS bf16_t*)(ws + OFF_BR); const GAS bf16_t* f64 = (const GAS bf16_t*)(ws + OFF_F64);
    const int b = un >> 7, k1 = un & 127;
    const int w = c.wave, kb = w & 1, lane = c.lane, r32 = lane & 31, hi = lane >> 5;
    LAS unsigned char* TT = c.lds;
    __syncthreads();
    for (int i = c.tid; i < 64 * 128; i += 512) { const int l2 = i >> 7, ch = i & 127; *(LAS u32x4*)(TT + l2 * 2112 + ch * 16) = *(const GAS u32x4*)(T + (size_t)(b * SEQ + k1 * 64 + l2) * 1024 + ch * 8); }
    bf16x8 fc[4], fs[4];
#pragma unroll
    for (int ks = 0; ks < 4; ++ks) { const GAS bf16_t* rp = f64 + (32 * kb + r32) * 64 + 16 * ks + 4 * hi;
        const u32x2 a = *(const GAS u32x2*)rp, bb = *(const GAS u32x2*)(rp + 8), sa = *(const GAS u32x2*)(rp + 4096), sb = *(const GAS u32x2*)(rp + 4096 + 8);
        fc[ks] = __builtin_bit_cast(bf16x8, (u32x4){a.x, a.y, bb.x, bb.y}); fs[ks] = __builtin_bit_cast(bf16x8, (u32x4){sa.x, sa.y, sb.x, sb.y}); }
    __syncthreads();
    for (int j = 0; j < 4; ++j) {
        const int cbk = (w >> 1) + 4 * j, g = cbk >> 1, mb = cbk & 1;
        f32x16 a1 = {}, a2 = {};
#pragma unroll
        for (int ks = 0; ks < 4; ++ks) {
            LAS unsigned char* pp = TT + (16 * ks + 4 * hi + ((lane & 15) >> 2)) * 2112 + (g * 128 + 32 * mb + 16 * ((lane >> 4) & 1) + 4 * (lane & 3)) * 2;
            const s16x4 x0 = lds_tr16(pp), x1 = lds_tr16(pp + 8 * 2112), y0 = lds_tr16(pp + 128), y1 = lds_tr16(pp + 128 + 8 * 2112);
            const bf16x8 br = (bf16x8){x0[0], x0[1], x0[2], x0[3], x1[0], x1[1], x1[2], x1[3]}, bp = (bf16x8){y0[0], y0[1], y0[2], y0[3], y1[0], y1[1], y1[2], y1[3]};
            a1 = __builtin_amdgcn_mfma_f32_32x32x16_bf16(fc[ks], br, a1, 0, 0, 0); a2 = __builtin_amdgcn_mfma_f32_32x32x16_bf16(fs[ks], bp, a2, 0, 0, 0);
        }
        GAS bf16_t* op = BR + (size_t)(b * SEQ + k1) * 2048 + 1024 + g * 64 + 32 * mb + r32;
#pragma unroll
        for (int r = 0; r < 16; ++r) { const int k2 = 32 * kb + crow16(r, hi); op[(size_t)k2 * 128 * 2048] = (bf16_t)f2bf((a1[r] - a2[r]) * 0.125f); }
    }
}

__device__ __forceinline__ void ctxfft_unit(const Ctx& c, GAS unsigned char* ws, int un) {
    const GAS bf16_t* V = (const GAS bf16_t*)(ws + OFF_V); GAS bf16_t* BR = (GAS bf16_t*)(ws + OFF_BR); const GAS bf16_t* f256 = (const GAS bf16_t*)(ws + OFF_F256);
    const int b = un >> 3, g = un & 7;
    const int kb = c.wave, lane = c.lane, r32 = lane & 31, hi = lane >> 5;
    LAS unsigned char* VT = c.lds;
    __syncthreads();
    for (int i = c.tid; i < 256 * 16; i += 512) { const int l = i >> 4, ch = i & 15; *(LAS u32x4*)(VT + l * 256 + ch * 16) = *(const GAS u32x4*)(V + (size_t)(NL + b * LC + l) * 1024 + g * 128 + ch * 8); }
    __syncthreads();
    const GAS bf16_t* crow = f256 + (size_t)(32 * kb + r32) * 256 + 4 * hi;
    for (int mb = 0; mb < 2; ++mb) {
        f32x16 a1 = {}, a2 = {};
#pragma unroll 4
        for (int ks = 0; ks < 16; ++ks) {
            const u32x2 ca = *(const GAS u32x2*)(crow + 16 * ks), cb2 = *(const GAS u32x2*)(crow + 16 * ks + 8), sa = *(const GAS u32x2*)(crow + 65536 + 16 * ks), sb = *(const GAS u32x2*)(crow + 65536 + 16 * ks + 8);
            const bf16x8 fc = __builtin_bit_cast(bf16x8, (u32x4){ca.x, ca.y, cb2.x, cb2.y}), fs = __builtin_bit_cast(bf16x8, (u32x4){sa.x, sa.y, sb.x, sb.y});
            LAS unsigned char* pp = VT + (16 * ks + 4 * hi + ((lane & 15) >> 2)) * 256 + (32 * mb + 16 * ((lane >> 4) & 1) + 4 * (lane & 3)) * 2;
            const s16x4 x0 = lds_tr16(pp), x1 = lds_tr16(pp + 2048), z0 = lds_tr16(pp + 128), z1 = lds_tr16(pp + 128 + 2048);
            const bf16x8 br = (bf16x8){x0[0], x0[1], x0[2], x0[3], x1[0], x1[1], x1[2], x1[3]}, bi = (bf16x8){z0[0], z0[1], z0[2], z0[3], z1[0], z1[1], z1[2], z1[3]};
            a1 = __builtin_amdgcn_mfma_f32_32x32x16_bf16(fc, br, a1, 0, 0, 0); a2 = __builtin_amdgcn_mfma_f32_32x32x16_bf16(fs, bi, a2, 0, 0, 0);
        }
        GAS bf16_t* op = BR + (size_t)(NL + b * LC) * 2048 + 1024 + g * 64 + 32 * mb + r32;
#pragma unroll
        for (int r = 0; r < 16; ++r) { const int k = 32 * kb + crow16(r, hi); op[(size_t)k * 2048] = (bf16_t)f2bf((a1[r] + a2[r]) * 0.0625f); }
    }
}

constexpr size_t OFF_S = OFF_V;
constexpr size_t OFF_DEC = OFF_TILEE + 4096;
__device__ __forceinline__ void chunk_rows(int b, int cidx, int& rbase, int& sbase, int& pos0, int& len) {
    if (cidx < 2) { sbase = NL + b * LC; pos0 = cidx * 128; len = LC; } else { sbase = b * SEQ; pos0 = (cidx - 2) * 128; len = SEQ; }
    rbase = sbase + pos0;
}
__device__ __forceinline__ void ssd_prep(const Ctx& c, GAS unsigned char* ws, int L, int h, int rbase) {
    const LAS Params& P = *c.p; const GAS float* DT = (const GAS float*)(ws + OFF_DT);
    LAS f32x4* ci = (LAS f32x4*)c.lds; LAS float* wf = (LAS float*)(c.lds + 2048); LAS float* wb = (LAS float*)(c.lds + 2560);
    LAS float* tmp = (LAS float*)(c.lds + 3072);
    __syncthreads();
    float dtf = 0.f, dtb = 0.f;
    if (c.tid < 128) {
        const float af = -__expf(gp(P.in[I_ALOG])[L * 16 + h]), ab = -__expf(gp(P.in[I_ALOG])[L * 16 + 8 + h]);
        dtf = softplus_f(DT[(size_t)(rbase + c.tid) * 16 + h] + gp(P.in[I_DTB])[L * 16 + h]);
        dtb = softplus_f(DT[(size_t)(rbase + c.tid) * 16 + 8 + h] + gp(P.in[I_DTB])[L * 16 + 8 + h]);
        tmp[c.tid] = af * dtf; tmp[128 + c.tid] = ab * dtb;
    }
    __syncthreads();
    if (c.tid < 128) {
        float cf = 0.f, rb = 0.f;
        for (int j = 0; j < 128; ++j) { const float a = tmp[j], bb = tmp[128 + j]; cf += (j <= c.tid) ? a : 0.f; rb += (j >= c.tid) ? bb : 0.f; }
        ci[c.tid] = (f32x4){cf, dtf, rb, dtb};
    }
    __syncthreads();
    if (c.tid < 128) { const f32x4 me = ci[c.tid]; const float cfe = ci[127].x, rb0 = ci[0].z; wf[c.tid] = me.y * __expf(cfe - me.x); wb[c.tid] = me.w * __expf(rb0 - me.z); }
    __syncthreads();
}
struct Raw3 { u32x4 x[3]; };
__device__ __forceinline__ Raw3 conv8_load(const GAS bf16_t* PX, int sbase, int pos, int len, int xc0) {
    Raw3 r;
#pragma unroll
    for (int t = 0; t < 3; ++t) { const int pp = pos + t - 1; const bool ok = (pp >= 0 && pp < len); const int pc = ok ? pp : pos;
        const u32x4 x = *(const GAS u32x4*)(PX + (size_t)(sbase + pc) * 2048 + 1280 + xc0); r.x[t] = ok ? x : (u32x4){0u, 0u, 0u, 0u}; }
    return r;
}
__device__ __forceinline__ void conv8_math(const Raw3& r, const GAS float* cw, const GAS float* cb, int xc0, float (&v)[8]) {
    { const f32x4 b0 = *(const GAS f32x4*)(cb + xc0), b1 = *(const GAS f32x4*)(cb + xc0 + 4); v[0] = b0.x; v[1] = b0.y; v[2] = b0.z; v[3] = b0.w; v[4] = b1.x; v[5] = b1.y; v[6] = b1.z; v[7] = b1.w; }
#pragma unroll
    for (int t = 0; t < 3; ++t) { const f32x4 w0 = *(const GAS f32x4*)(cw + t * 768 + xc0), w1 = *(const GAS f32x4*)(cw + t * 768 + xc0 + 4); const u32x4 x = r.x[t];
        v[0] += w0.x * bflo(x[0]); v[1] += w0.y * bfhi(x[0]); v[2] += w0.z * bflo(x[1]); v[3] += w0.w * bfhi(x[1]);
        v[4] += w1.x * bflo(x[2]); v[5] += w1.y * bfhi(x[2]); v[6] += w1.z * bflo(x[3]); v[7] += w1.w * bfhi(x[3]); }
#pragma unroll
    for (int e = 0; e < 8; ++e) v[e] = silu_f(v[e]);
}
constexpr int CONVW_LDS = 139264;
__device__ __forceinline__ void conv_table_stage(const Ctx& c, const GAS float* cw, const GAS float* cb) {
    LAS float* t = (LAS float*)(c.lds + CONVW_LDS);
    for (int i = c.tid; i < 3 * 768; i += 512) t[i] = cw[i];
    for (int i = c.tid; i < 768; i += 512) t[3 * 768 + i] = cb[i];
    __syncthreads();
}
__device__ __forceinline__ void conv8_math_l(const Raw3& r, const LAS float* tb, int xc0, float (&v)[8]) {
    { const f32x4 b0 = *(const LAS f32x4*)(tb + 3 * 768 + xc0), b1 = *(const LAS f32x4*)(tb + 3 * 768 + xc0 + 4); v[0] = b0.x; v[1] = b0.y; v[2] = b0.z; v[3] = b0.w; v[4] = b1.x; v[5] = b1.y; v[6] = b1.z; v[7] = b1.w; }
#pragma unroll
    for (int t = 0; t < 3; ++t) { const f32x4 w0 = *(const LAS f32x4*)(tb + t * 768 + xc0), w1 = *(const LAS f32x4*)(tb + t * 768 + xc0 + 4); const u32x4 x = r.x[t];
        v[0] += w0.x * bflo(x[0]); v[1] += w0.y * bfhi(x[0]); v[2] += w0.z * bflo(x[1]); v[3] += w0.w * bfhi(x[1]);
        v[4] += w1.x * bflo(x[2]); v[5] += w1.y * bfhi(x[2]); v[6] += w1.z * bflo(x[3]); v[7] += w1.w * bfhi(x[3]); }
#pragma unroll
    for (int e = 0; e < 8; ++e) v[e] = silu_f(v[e]);
}
__device__ __forceinline__ void conv8(const GAS bf16_t* PX, const GAS float* cw, const GAS float* cb, int sbase, int pos, int len, int xc0, float (&v)[8]) {
    const Raw3 r = conv8_load(PX, sbase, pos, len, xc0); conv8_math(r, cw, cb, xc0, v);
}
__device__ __forceinline__ u32x4 pack8(const float (&v)[8], float sc) { u32x4 o; o.x = pk2(v[0] * sc, v[1] * sc); o.y = pk2(v[2] * sc, v[3] * sc); o.z = pk2(v[4] * sc, v[5] * sc); o.w = pk2(v[6] * sc, v[7] * sc); return o; }
__device__ __forceinline__ bf16x8 tr_frag(LAS unsigned char* tile, int ks, int col32, int lane) {
    const int hi = lane >> 5;
    LAS unsigned char* pp = tile + (16 * ks + 4 * hi + ((lane & 15) >> 2)) * 128 + (col32 + 16 * ((lane >> 4) & 1) + 4 * (lane & 3)) * 2;
    const s16x4 a = lds_tr16(pp), b = lds_tr16(pp + 1024);
    return (bf16x8){a[0], a[1], a[2], a[3], b[0], b[1], b[2], b[3]};
}
__device__ __forceinline__ void ssd_state_unit(const Ctx& c, GAS unsigned char* ws, int L, int un) {
    const LAS Params& P = *c.p;
    const GAS bf16_t* PX = (const GAS bf16_t*)(ws + OFF_PX); GAS float* S = (GAS float*)(ws + OFF_S); GAS float* DEC = (GAS float*)(ws + OFF_DEC);
    const GAS float* cw = gp(P.in[I_CONVW]) + (size_t)L * 3 * 768; const GAS float* cb = gp(P.in[I_CONVB]) + (size_t)L * 768;
    const int h = un & 7, bc = un >> 3, b = bc / 66, cidx = bc % 66, grp = h >> 2;
    int rbase, sbase, pos0, len; chunk_rows(b, cidx, rbase, sbase, pos0, len);
    const bool doc = (h & 3) == 1;
    Raw3 rx[2], rb[2], rc[2];
#pragma unroll
    for (int k = 0; k < 2; ++k) { const int it = c.tid + 512 * k, q = it >> 3, g8 = it & 7;
        rx[k] = conv8_load(PX, sbase, pos0 + q, len, h * 64 + g8 * 8); rb[k] = conv8_load(PX, sbase, pos0 + q, len, 512 + grp * 64 + g8 * 8);
        if (doc) rc[k] = conv8_load(PX, sbase, pos0 + q, len, 640 + grp * 64 + g8 * 8); }
    ssd_prep(c, ws, L, h, rbase);
    LAS f32x4* ci = (LAS f32x4*)c.lds; const LAS float* wf = (const LAS float*)(c.lds + 2048); const LAS float* wb = (const LAS float*)(c.lds + 2560);
    LAS unsigned char* XF = c.lds + 4096; LAS unsigned char* XB = XF + 16384; LAS unsigned char* BT = XB + 16384;
    GAS bf16_t* XBC = (GAS bf16_t*)(ws + OFF_XBC);
    if (c.tid < 128) ((GAS f32x4*)(ws + OFF_CI))[(size_t)un * 128 + c.tid] = ci[c.tid];
#pragma unroll
    for (int k = 0; k < 2; ++k) { const int it = c.tid + 512 * k, q = it >> 3, g8 = it & 7; float v[8];
        conv8_math(rx[k], cw, cb, h * 64 + g8 * 8, v); *(LAS u32x4*)(XF + q * 128 + g8 * 16) = pack8(v, wf[q]); *(LAS u32x4*)(XB + q * 128 + g8 * 16) = pack8(v, wb[q]);
        *(GAS u32x4*)(XBC + (size_t)(rbase + q) * 768 + h * 64 + g8 * 8) = pack8(v, 1.f);
        conv8_math(rb[k], cw, cb, 512 + grp * 64 + g8 * 8, v); const u32x4 pk = pack8(v, 1.f); *(LAS u32x4*)(BT + q * 128 + g8 * 16) = pk;
        if ((h & 3) == 0) *(GAS u32x4*)(XBC + (size_t)(rbase + q) * 768 + 512 + grp * 64 + g8 * 8) = pk;
        if (doc) { conv8_math(rc[k], cw, cb, 640 + grp * 64 + g8 * 8, v); *(GAS u32x4*)(XBC + (size_t)(rbase + q) * 768 + 640 + grp * 64 + g8 * 8) = pack8(v, 1.f); } }
    __syncthreads();
    const int w = c.wave, dir = w >> 2, pt = (w >> 1) & 1, nt = w & 1, lane = c.lane, r32 = lane & 31, hi = lane >> 5;
    LAS unsigned char* XT = dir ? XB : XF;
    f32x16 acc = {};
#pragma unroll
    for (int ks = 0; ks < 8; ++ks) { const bf16x8 a = tr_frag(XT, ks, 32 * pt, lane), bb = tr_frag(BT, ks, 32 * nt, lane); acc = __builtin_amdgcn_mfma_f32_32x32x16_bf16(a, bb, acc, 0, 0, 0); }
    GAS float* so = S + ((((size_t)(b * 66 + cidx) * 8 + h) * 2 + dir) << 12);
#pragma unroll
    for (int r = 0; r < 16; ++r) so[(32 * pt + crow16(r, hi)) * 64 + 32 * nt + r32] = acc[r];
    if (c.tid == 0) { DEC[((b * 66 + cidx) * 8 + h) * 2] = __expf(ci[127].x); DEC[((b * 66 + cidx) * 8 + h) * 2 + 1] = __expf(ci[0].z); }
}
__device__ __forceinline__ void ssd_state_pair_unit(const Ctx& c, GAS unsigned char* ws, int L, int un) {
    const LAS Params& P = *c.p;
    const GAS bf16_t* PX = (const GAS bf16_t*)(ws + OFF_PX); GAS float* S = (GAS float*)(ws + OFF_S); GAS float* DEC = (GAS float*)(ws + OFF_DEC); const GAS float* DT = (const GAS float*)(ws + OFF_DT);
    const GAS float* cw = gp(P.in[I_CONVW]) + (size_t)L * 3 * 768; const GAS float* cb = gp(P.in[I_CONVB]) + (size_t)L * 768;
    const int hp = un & 3, bc = un >> 2, b = bc / 66, cidx = bc % 66, grp = hp >> 1, h0 = 2 * hp;
    int rbase, sbase, pos0, len; chunk_rows(b, cidx, rbase, sbase, pos0, len);
    const LAS float* ctab = (const LAS float*)(c.lds + CONVW_LDS);
    const bool dobc = (hp & 1) == 0;
    LAS f32x4* ci = (LAS f32x4*)c.lds;
    LAS float* wf = (LAS float*)(c.lds + 4096); LAS float* wb = (LAS float*)(c.lds + 5120); LAS float* tmp = (LAS float*)(c.lds + 6144);
    LAS unsigned char* XF = c.lds + 8192; LAS unsigned char* XB = XF + 32768; LAS unsigned char* BT = XB + 32768;
    Raw3 rx[4], rb[2];
#pragma unroll
    for (int k = 0; k < 4; ++k) { const int it = c.tid + 512 * k, hh = it >> 10, q = (it >> 3) & 127, g8 = it & 7; rx[k] = conv8_load(PX, sbase, pos0 + q, len, (h0 + hh) * 64 + g8 * 8); }
#pragma unroll
    for (int k = 0; k < 2; ++k) { const int it = c.tid + 512 * k, q = it >> 3, g8 = it & 7; rb[k] = conv8_load(PX, sbase, pos0 + q, len, 512 + grp * 64 + g8 * 8); }
    __syncthreads();
    float dtf = 0.f, dtb = 0.f; const int hh_t = c.tid >> 7, i_t = c.tid & 127;
    if (c.tid < 256) { const int h = h0 + hh_t;
        const float af = -__expf(gp(P.in[I_ALOG])[L * 16 + h]), ab = -__expf(gp(P.in[I_ALOG])[L * 16 + 8 + h]);
        dtf = softplus_f(DT[(size_t)(rbase + i_t) * 16 + h] + gp(P.in[I_DTB])[L * 16 + h]);
        dtb = softplus_f(DT[(size_t)(rbase + i_t) * 16 + 8 + h] + gp(P.in[I_DTB])[L * 16 + 8 + h]);
        tmp[hh_t * 256 + i_t] = af * dtf; tmp[hh_t * 256 + 128 + i_t] = ab * dtb; }
    __syncthreads();
    if (c.tid < 256) { float cf = 0.f, rbv = 0.f; const LAS float* tp = tmp + hh_t * 256;
        for (int j = 0; j < 128; ++j) { const float a = tp[j], bb = tp[128 + j]; cf += (j <= i_t) ? a : 0.f; rbv += (j >= i_t) ? bb : 0.f; }
        ci[c.tid] = (f32x4){cf, dtf, rbv, dtb}; }
    __syncthreads();
    if (c.tid < 256) { const f32x4 me = ci[c.tid]; const float cfe = ci[hh_t * 128 + 127].x, rb0 = ci[hh_t * 128].z; wf[c.tid] = me.y * __expf(cfe - me.x); wb[c.tid] = me.w * __expf(rb0 - me.z);
        ((GAS f32x4*)(ws + OFF_CI))[((size_t)bc * 8 + h0 + hh_t) * 128 + i_t] = me; }
    __syncthreads();
    GAS bf16_t* XBC = (GAS bf16_t*)(ws + OFF_XBC);
#pragma unroll
    for (int k = 0; k < 4; ++k) { const int it = c.tid + 512 * k, hh = it >> 10, q = (it >> 3) & 127, g8 = it & 7; float v[8];
        conv8_math_l(rx[k], ctab, (h0 + hh) * 64 + g8 * 8, v);
        *(LAS u32x4*)(XF + hh * 16384 + q * 128 + g8 * 16) = pack8(v, wf[hh * 128 + q]); *(LAS u32x4*)(XB + hh * 16384 + q * 128 + g8 * 16) = pack8(v, wb[hh * 128 + q]);
        *(GAS u32x4*)(XBC + (size_t)(rbase + q) * 768 + (h0 + hh) * 64 + g8 * 8) = pack8(v, 1.f); }
#pragma unroll
    for (int k = 0; k < 2; ++k) { const int it = c.tid + 512 * k, q = it >> 3, g8 = it & 7; float v[8];
        conv8_math_l(rb[k], ctab, 512 + grp * 64 + g8 * 8, v); const u32x4 pk = pack8(v, 1.f); *(LAS u32x4*)(BT + q * 128 + g8 * 16) = pk;
        if (dobc) *(GAS u32x4*)(XBC + (size_t)(rbase + q) * 768 + 512 + grp * 64 + g8 * 8) = pk; }
    if (dobc) {
#pragma unroll
        for (int k = 0; k < 2; ++k) { const int it = c.tid + 512 * k, q = it >> 3, g8 = it & 7; float v[8];
            { const Raw3 rc_ = conv8_load(PX, sbase, pos0 + q, len, 640 + grp * 64 + g8 * 8); conv8_math_l(rc_, ctab, 640 + grp * 64 + g8 * 8, v); } *(GAS u32x4*)(XBC + (size_t)(rbase + q) * 768 + 640 + grp * 64 + g8 * 8) = pack8(v, 1.f); } }
    __syncthreads();
    const int w = c.wave, hh = w >> 2, dir = (w >> 1) & 1, pt = w & 1, lane = c.lane, r32 = lane & 31, hi = lane >> 5;
    LAS unsigned char* XT = (dir ? XB : XF) + hh * 16384;
    GAS float* so = S + ((((size_t)bc * 8 + h0 + hh) * 2 + dir) << 12);
#pragma unroll
    for (int nt = 0; nt < 2; ++nt) {
        f32x16 acc = {};
#pragma unroll
        for (int ks = 0; ks < 8; ++ks) { const bf16x8 a = tr_frag(XT, ks, 32 * pt, lane), bb = tr_frag(BT, ks, 32 * nt, lane); acc = __builtin_amdgcn_mfma_f32_32x32x16_bf16(a, bb, acc, 0, 0, 0); }
#pragma unroll
        for (int r = 0; r < 16; ++r) so[(32 * pt + crow16(r, hi)) * 64 + 32 * nt + r32] = acc[r];
    }
    if (c.tid < 2) { const int h = h0 + c.tid; DEC[(bc * 8 + h) * 2] = __expf(ci[c.tid * 128 + 127].x); DEC[(bc * 8 + h) * 2 + 1] = __expf(ci[c.tid * 128].z); }
}
__device__ __forceinline__ void ph_ssd_scan(const Ctx& c, GAS unsigned char* ws) {
    GAS f32x2* S = (GAS f32x2*)(ws + OFF_S); const GAS float* DEC = (const GAS float*)(ws + OFF_DEC);
    for (int it = c.bid * 512 + c.tid; it < 4 * 8 * 2 * 2048; it += c.nblk * 512) {
        const int e = it & 2047, dir = (it >> 11) & 1, h = (it >> 12) & 7, b = it >> 15;
        f32x2 st = {0.f, 0.f};
        for (int k0 = 0; k0 < 66; k0 += 11) {
            f32x2 t[11]; float d[11]; size_t off[11];
#pragma unroll
            for (int u = 0; u < 11; ++u) { const int k = k0 + u; const int cidx = dir ? ((k < 2) ? (1 - k) : (67 - k)) : k;
                const size_t sidx = ((size_t)(b * 66 + cidx) * 8 + h) * 2 + dir; off[u] = (sidx << 11) + e; t[u] = S[off[u]]; d[u] = DEC[sidx]; }
#pragma unroll
            for (int u = 0; u < 11; ++u) { S[off[u]] = st; st = st * d[u] + t[u]; }
        }
    }
}
__device__ __forceinline__ void ssd_out_unit(const Ctx& c, GAS unsigned char* ws, int L, int un) {
    const LAS Params& P = *c.p;
    const GAS bf16_t* PX = (const GAS bf16_t*)(ws + OFF_PX); GAS bf16_t* BR = (GAS bf16_t*)(ws + OFF_BR); const GAS float* S = (const GAS float*)(ws + OFF_S);
    const GAS float* cw = gp(P.in[I_CONVW]) + (size_t)L * 3 * 768; const GAS float* cb = gp(P.in[I_CONVB]) + (size_t)L * 768;
    const int h = un & 7, bc = un >> 3, b = bc / 66, cidx = bc % 66, grp = h >> 2;
    int rbase, sbase, pos0, len; chunk_rows(b, cidx, rbase, sbase, pos0, len);
    LAS f32x4* ci = (LAS f32x4*)c.lds;
    LAS unsigned char* XT = c.lds + 4096; LAS unsigned char* BT = XT + 16384; LAS unsigned char* CT = BT + 16384;
    const GAS bf16_t* XBC = (const GAS bf16_t*)(ws + OFF_XBC);
    f32x4 sfr[2][4][2];
    { const int ph_ = c.wave >> 2, r32_ = c.lane & 31, hi_ = c.lane >> 5;
#pragma unroll
      for (int dir = 0; dir < 2; ++dir) { const GAS float* sp = S + ((((size_t)(b * 66 + cidx) * 8 + h) * 2 + dir) << 12) + (32 * ph_ + r32_) * 64;
#pragma unroll
          for (int s4 = 0; s4 < 4; ++s4) { sfr[dir][s4][0] = *(const GAS f32x4*)(sp + 16 * s4 + 8 * hi_); sfr[dir][s4][1] = *(const GAS f32x4*)(sp + 16 * s4 + 8 * hi_ + 4); } } }
    __syncthreads();
    { f32x4 civ; if (c.tid < 128) civ = ((const GAS f32x4*)(ws + OFF_CI))[(size_t)un * 128 + c.tid];
      u32x4 tx[2], tb[2], tc[2];
#pragma unroll
      for (int k = 0; k < 2; ++k) { const int it = c.tid + 512 * k, q = it >> 3, g8 = it & 7; const GAS bf16_t* rp = XBC + (size_t)(rbase + q) * 768 + g8 * 8;
          tx[k] = *(const GAS u32x4*)(rp + h * 64); tb[k] = *(const GAS u32x4*)(rp + 512 + grp * 64); tc[k] = *(const GAS u32x4*)(rp + 640 + grp * 64); }
      if (c.tid < 128) ci[c.tid] = civ;
#pragma unroll
      for (int k = 0; k < 2; ++k) { const int it = c.tid + 512 * k, q = it >> 3, g8 = it & 7;
          *(LAS u32x4*)(XT + q * 128 + g8 * 16) = tx[k]; *(LAS u32x4*)(BT + q * 128 + ((g8 ^ (q & 7)) * 16)) = tb[k]; *(LAS u32x4*)(CT + q * 128 + ((g8 ^ (q & 7)) * 16)) = tc[k]; } }
    __syncthreads();
    const int w = c.wave, ib = w & 3, ph = w >> 2, lane = c.lane, r32 = lane & 31, hi = lane >> 5;
    const int i = 32 * ib + r32;
    const f32x4 cii = ci[i];
    bf16x8 cfr[4];
#pragma unroll
    for (int s = 0; s < 4; ++s) cfr[s] = *(const LAS bf16x8*)(CT + i * 128 + (((2 * s + hi) ^ (i & 7)) * 16));
    u32x4 pw[8];
#pragma unroll
    for (int jb = 0; jb < 4; ++jb) {
        f32x16 x = {};
        const int jrow = 32 * jb + r32;
#pragma unroll
        for (int s = 0; s < 4; ++s) { const bf16x8 bf = *(const LAS bf16x8*)(BT + jrow * 128 + (((2 * s + hi) ^ (jrow & 7)) * 16)); x = __builtin_amdgcn_mfma_f32_32x32x16_bf16(bf, cfr[s], x, 0, 0, 0); }
        if (jb < ib) {
#pragma unroll
            for (int r = 0; r < 16; ++r) { const f32x4 cj = ci[32 * jb + crow16(r, hi)]; x[r] *= __expf(cii.x - cj.x) * cj.y; }
        } else if (jb > ib) {
#pragma unroll
            for (int r = 0; r < 16; ++r) { const f32x4 cj = ci[32 * jb + crow16(r, hi)]; x[r] *= __expf(cii.z - cj.z) * cj.w; }
        } else {
#pragma unroll
            for (int r = 0; r < 16; ++r) { const int j = 32 * jb + crow16(r, hi); const f32x4 cj = ci[j];
                float f;
                if (j < i) f = __expf(cii.x - cj.x) * cj.y; else if (j > i) f = __expf(cii.z - cj.z) * cj.w; else f = cj.y + cj.w;
                x[r] *= f; }
        }
#pragma unroll
        for (int q = 0; q < 4; ++q) { pw[2 * jb][q] = cvtpk(x[2 * q], x[2 * q + 1]); pw[2 * jb + 1][q] = cvtpk(x[8 + 2 * q], x[8 + 2 * q + 1]); }
    }
    f32x16 y = {};
#pragma unroll
    for (int ks = 0; ks < 8; ++ks) { const bf16x8 a = tr_frag(XT, ks, 32 * ph, lane); y = __builtin_amdgcn_mfma_f32_32x32x16_bf16(a, __builtin_bit_cast(bf16x8, pw[ks]), y, 0, 0, 0); }
#pragma unroll
    for (int dir = 0; dir < 2; ++dir) {
        f32x16 z = {};
#pragma unroll
        for (int s = 0; s < 4; ++s) { const f32x4 a0 = sfr[dir][s][0], a1 = sfr[dir][s][1];
            u32x4 aw; aw.x = cvtpk(a0.x, a0.y); aw.y = cvtpk(a0.z, a0.w); aw.z = cvtpk(a1.x, a1.y); aw.w = cvtpk(a1.z, a1.w);
            z = __builtin_amdgcn_mfma_f32_32x32x16_bf16(__builtin_bit_cast(bf16x8, aw), cfr[s], z, 0, 0, 0); }
        const float sc = __expf(dir ? cii.z : cii.x);
#pragma unroll
        for (int r = 0; r < 16; ++r) y[r] += z[r] * sc;
    }
    const float dsk = gp(P.in[I_SSMD])[L * 8 + h];
    GAS bf16_t* op = BR + (size_t)(rbase + i) * 2048 + 512 + h * 64 + 32 * ph + 4 * hi;
#pragma unroll
    for (int g4 = 0; g4 < 4; ++g4) { const u32x2 xv = *(const LAS u32x2*)(XT + i * 128 + (32 * ph + 8 * g4 + 4 * hi) * 2);
        u32x2 o; o.x = cvtpk(y[4 * g4] + dsk * bflo(xv.x), y[4 * g4 + 1] + dsk * bfhi(xv.x)); o.y = cvtpk(y[4 * g4 + 2] + dsk * bflo(xv.y), y[4 * g4 + 3] + dsk * bfhi(xv.y));
        *(GAS u32x2*)(op + 8 * g4) = o; }
}
__device__ __forceinline__ void ph_ssm_out2(const Ctx& c, GAS unsigned char* ws, int L, int nrows) {
    const LAS Params& P = *c.p;
    const GAS bf16_t* PX = (const GAS bf16_t*)(ws + OFF_PX); GAS bf16_t* BR = (GAS bf16_t*)(ws + OFF_BR); const GAS float* nw = gp(P.in[I_SSMNW]) + (size_t)L * 512;
    const int c0 = c.lane * 8;
    const f32x4 nw0 = *(const GAS f32x4*)(nw + c0), nw1 = *(const GAS f32x4*)(nw + c0 + 4);
    const float nwr[8] = {nw0.x, nw0.y, nw0.z, nw0.w, nw1.x, nw1.y, nw1.z, nw1.w};
    u32x4 nyv = {}, nzz = {};
    if (c.gw < nrows) { nyv = *(const GAS u32x4*)(BR + (size_t)c.gw * 2048 + 512 + c0); nzz = *(const GAS u32x4*)(PX + (size_t)c.gw * 2048 + 768 + c0); }
    for (int row = c.gw; row < nrows; row += c.ngw) {
        const u32x4 yv = nyv, zz = nzz;
        if (row + c.ngw < nrows) { nyv = *(const GAS u32x4*)(BR + (size_t)(row + c.ngw) * 2048 + 512 + c0); nzz = *(const GAS u32x4*)(PX + (size_t)(row + c.ngw) * 2048 + 768 + c0); }
        float y[8]; float ss = 0.f;
#pragma unroll
        for (int e = 0; e < 8; ++e) { const float f = (e & 1) ? bfhi(yv[e >> 1]) : bflo(yv[e >> 1]), z = (e & 1) ? bfhi(zz[e >> 1]) : bflo(zz[e >> 1]); y[e] = f * silu_f(z); ss += y[e] * y[e]; }
        const float rs = rsqrtf(wave_sum(ss) * (1.f / 512.f) + EPS);
        u32x4 o;
#pragma unroll
        for (int hh = 0; hh < 4; ++hh) o[hh] = pk2(y[2 * hh] * rs * nwr[2 * hh], y[2 * hh + 1] * rs * nwr[2 * hh + 1]);
        *(GAS u32x4*)(BR + (size_t)row * 2048 + 512 + c0) = o;
    }
}

constexpr size_t OFF_BAR = 16 * 1024;
#define XB_TMO      128
#define XB_XCNT(j)  (256  + 64 * (j))
#define XB_XSUB(j)  (1280 + 64 * (j))
#define XB_XGEN(j)  (2304 + 64 * (j))
#define XB_TOP      3328
#define XB_TOPGEN   3392
#define XCD_BAR_WORDS 3456
#define XB_SPIN_CAP (1u << 18)
__device__ __forceinline__ unsigned xb_ld(GAS unsigned* p)              { return __hip_atomic_load(p, __ATOMIC_RELAXED, __HIP_MEMORY_SCOPE_AGENT); }
__device__ __forceinline__ unsigned xb_add(GAS unsigned* p, unsigned v) { return __hip_atomic_fetch_add(p, v, __ATOMIC_RELAXED, __HIP_MEMORY_SCOPE_AGENT); }
__device__ __forceinline__ unsigned xb_xcc_id() { return (unsigned)__builtin_amdgcn_s_getreg((3 << 11) | 20) & 0xFu; }
#define XB_SPIN(cond, bar) do { unsigned _sp = 0; while (cond) { __builtin_amdgcn_s_sleep(1); \
    if ((++_sp & 255u) == 0u) { if (xb_ld(&(bar)[XB_TMO])) break; if (_sp > XB_SPIN_CAP) { xb_add(&(bar)[XB_TMO], 1u); break; } } } } while (0)
struct XcdBarrier { GAS unsigned* bar; unsigned x; volatile LAS unsigned* st; };
__device__ __forceinline__ XcdBarrier xcd_barrier_post(GAS unsigned* bar, volatile LAS unsigned* st) {
    XcdBarrier b; b.bar = bar; b.x = xb_xcc_id(); b.st = st;
    if (threadIdx.x == 0) st[2] = xb_add(&bar[XB_XCNT(b.x)], 1u);
    return b;
}
__device__ __forceinline__ void xcd_barrier_complete(GAS unsigned* bar, unsigned x, unsigned& nloc, unsigned& nx) {
    const unsigned G = gridDim.x * gridDim.y * gridDim.z;
    unsigned sum, cnt, mine, msk, sp = 0u;
    for (;;) {
        sum = 0u; cnt = 0u; mine = 0u; msk = 0u;
#pragma unroll
        for (unsigned j = 0; j < 16; ++j) { const unsigned c = xb_ld(&bar[XB_XCNT(j)]); sum += c; cnt += (c > 0u) ? 1u : 0u; msk |= (c > 0u) ? (1u << j) : 0u; mine = (j == x) ? c : mine; }
        if (sum == G) break;
        __builtin_amdgcn_s_sleep(1);
        if ((++sp & 255u) == 0u) { if (xb_ld(&bar[XB_TMO])) break; if (sp > XB_SPIN_CAP) { xb_add(&bar[XB_TMO], 1u); break; } }
    }
    nloc = mine > 0u ? mine : 1u; nx = (cnt > 0u ? cnt : 1u) | (msk << 8);
}
__device__ __forceinline__ void xcd_barrier(const XcdBarrier& b) {
    asm volatile("s_waitcnt vmcnt(0)" ::: "memory");
    __syncthreads();
    if (threadIdx.x == 0) {
        GAS unsigned* bar = b.bar;
        __builtin_amdgcn_s_waitcnt(0);
        unsigned nloc = b.st[0], nxm = b.st[1];
        if (nloc == 0u) { xcd_barrier_complete(bar, b.x, nloc, nxm); b.st[0] = nloc; b.st[1] = nxm; }
        const unsigned nx = nxm & 0xFFu, xmask = nxm >> 8;
        const unsigned old = xb_add(&bar[XB_XSUB(b.x)], 1u);
        const unsigned gen = old / nloc;
        if (old + 1u == (gen + 1u) * nloc) {
            __builtin_amdgcn_fence(__ATOMIC_RELEASE, "agent");
            asm volatile("s_waitcnt vmcnt(0)" ::: "memory");
            const unsigned og = xb_add(&bar[XB_TOP], 1u);
            const unsigned tg = og / nx;
            if (og + 1u == (tg + 1u) * nx) {
#pragma unroll
                for (unsigned j = 0; j < 16; ++j) if (xmask & (1u << j)) xb_add(&bar[XB_XGEN(j)], 1u);
            } else XB_SPIN(xb_ld(&bar[XB_XGEN(b.x)]) == gen, bar);
            __builtin_amdgcn_fence(__ATOMIC_ACQUIRE, "agent");
            asm volatile("s_waitcnt vmcnt(0)" ::: "memory");
        } else {
            XB_SPIN(xb_ld(&bar[XB_XGEN(b.x)]) == gen, bar);
            __builtin_amdgcn_fence(__ATOMIC_ACQUIRE, "agent");
            asm volatile("s_waitcnt vmcnt(0)" ::: "memory");
        }
    }
    __syncthreads();
}

__global__ void __launch_bounds__(512, 2) mega_fwd(Params P) {
    extern __shared__ __attribute__((aligned(16))) unsigned char lds_raw[];
    cg::grid_group grid = cg::this_grid();
    Ctx c; c.lds = (LAS unsigned char*)lds_raw; c.tid = threadIdx.x; c.lane = c.tid & 63; c.wave = __builtin_amdgcn_readfirstlane(c.tid >> 6);
    c.bid = blockIdx.x; c.nblk = gridDim.x; c.gw = c.bid * 8 + c.wave; c.ngw = c.nblk * 8; c.vbid = c.bid;
    { LAS Params* lp = (LAS Params*)(c.lds + LDS_PARAMS); if (c.tid < 29) ((LAS unsigned long long*)lp)[c.tid] = ((const GAS unsigned long long*)&P)[c.tid]; c.p = lp; }
    __syncthreads();
    GAS unsigned char* ws = gp(P.ws);
    GAS unsigned char* wb = ws + OFF_W;
    const GAS bf16_t* H = (const GAS bf16_t*)(ws + OFF_H);

#define SYNC() do { XcdBarrier xb_; xb_.bar = (GAS unsigned*)(ws + OFF_BAR); xb_.x = xb_xcc_id(); xb_.st = (volatile LAS unsigned*)(c.lds + LDS_PARAMS - 16); xcd_barrier(xb_); } while (0)
#define REFRESH() do { int t_ = threadIdx.x; asm volatile("" : "+v"(t_)); c.tid = t_; c.lane = t_ & 63; c.wave = __builtin_amdgcn_readfirstlane(t_ >> 6); { int b_ = blockIdx.x, n_ = gridDim.x; asm volatile("" : "+s"(b_), "+s"(n_)); c.bid = b_; c.nblk = n_; } c.gw = c.bid * 8 + c.wave; c.ngw = c.nblk * 8; c.vbid = (int)__builtin_amdgcn_readfirstlane((int)((volatile LAS unsigned*)(c.lds + LDS_PARAMS - 16))[3]); \
    asm volatile("" : "+s"(ws)); wb = ws + OFF_W; H = (const GAS bf16_t*)(ws + OFF_H); } while (0)

    volatile LAS unsigned* xst = (volatile LAS unsigned*)(c.lds + LDS_PARAMS - 16);
    if (c.tid < 4) xst[c.tid] = (c.tid == 3) ? (unsigned)blockIdx.x : 0u;
    __syncthreads();
    (void)xcd_barrier_post((GAS unsigned*)(ws + OFF_BAR), xst);
    const bool defer_w = (gridDim.x == 256);
    ph_tables(c, ws); for (int rep = 0; rep < REP_W; ++rep) { ph_mod(c, ws); __syncthreads(); ph_weights(c, ws, 0, 0, defer_w ? 256 : (1 << 30), 0, defer_w ? 1536 : (1 << 30)); __syncthreads(); }
    SYNC(); REFRESH();
    for (int rep = 0; rep < REP_N; ++rep) { ph_norm1_init(c, ws); __syncthreads(); }
    SYNC();
    if (c.tid == 0) { GAS unsigned* bar = (GAS unsigned*)(ws + OFF_BAR); bool ok = (c.nblk % 8) == 0; const unsigned per = (unsigned)c.nblk / 8u;
        for (unsigned j = 0; j < 16; ++j) { const unsigned cn = xb_ld(&bar[XB_XCNT(j)]); ok = ok && (cn == ((j < 8) ? per : 0u)); }
        const unsigned x = xb_xcc_id(); xst[3] = (ok && x < 8u && xst[2] < per) ? (xst[2] * 8u + x) : (unsigned)blockIdx.x; }
    __syncthreads();
    REFRESH();
    for (int L = 0; L < DEPTH; ++L) {
        const bool need_ctx = (L + 1 < DEPTH);
        const int nrows = need_ctx ? NT : NL;
        const int nMfull = NT / 256, nMr = nrows / 256;
        const GAS float* MODL = (const GAS float*)(ws + OFF_MOD) + (size_t)L * 5 * 6144;
        { pg8::SchedDense S; S.o.init(need_ctx ? nMfull : NL / 256, 8, c.nblk, c.vbid); S.A = (const GAS char*)(ws + OFF_H8); S.Bt = (const GAS char*)(wb + W_IN) + (size_t)2048 * 1024; S.a_tile = (size_t)256 * 1024; S.b_tile = (size_t)256 * 1024; S.a_colgrp = 0; S.colgrp_shift = 0; S.cs = (const GAS float*)(ws + OFF_CS) + 2048; S.rs = (const GAS float*)(ws + OFF_HS);
          pg8::EpiStore E{(GAS bf16_t*)(ws + OFF_PX), 2048, 0, nullptr, 0, c.lds + 131072};
          for (int rep = 0; rep < REP_G; ++rep) pg8::gemm_phase<pg8::EpiStore, pg8::SchedDense, false, 2>(c.lds, 8, 1024, 1024, S, E); }
        if (defer_w && L == 0 && c.vbid >= 32) ph_weights(c, ws, 0, 256, 704, 0, 0, c.vbid - 32, 224);
        SYNC(); REFRESH();
        for (int rep = 0; rep < REP_M; ++rep) {
        ph_shortconv(c, ws, L, nrows);
        if (need_ctx) ph_chandft(c, ws, NL, NT);
        fft1_setup(c, ws);
        for (int w = c.bid; w < 256; w += c.nblk) fft1_unit(c, ws, w); }
        SYNC(); REFRESH();
        { pg8::SchedDense S; S.o.init(nMfull, 8, c.nblk, c.vbid); S.A = (const GAS char*)(ws + OFF_H8); S.Bt = (const GAS char*)(wb + W_IN); S.a_tile = (size_t)256 * 1024; S.b_tile = (size_t)256 * 1024; S.a_colgrp = 0; S.colgrp_shift = 0; S.cs = (const GAS float*)(ws + OFF_CS); S.rs = (const GAS float*)(ws + OFF_HS);
          pg8::EpiStore E{(GAS bf16_t*)(ws + OFF_PX), 2048, 1, (const GAS f32x2*)(ws + OFF_ROPE), 0, c.lds + 131072};
          for (int rep = 0; rep < REP_G; ++rep) pg8::gemm_phase<pg8::EpiStore, pg8::SchedDense, false, 2>(c.lds, 8, 1024, 1024, S, E); }
        const int nlate = (nMfull * 8) % c.nblk, ntail = c.nblk - nlate, nctxf = need_ctx ? 32 : 0;
        const int nfc_early = (nlate > 0) ? max(0, min(512, 2 * ntail - nctxf)) : 0;
        if (nlate > 0 && c.vbid >= nlate) for (int it = c.vbid - nlate; it < nctxf + nfc_early; it += ntail) { __syncthreads(); if (it < nctxf) ctxfft_unit(c, ws, it); else fft2_unit(c, ws, it - nctxf); }
        SYNC(); REFRESH();
        conv_table_stage(c, gp(c.p->in[I_CONVW]) + (size_t)L * 3 * 768, gp(c.p->in[I_CONVB]) + (size_t)L * 768);
        { const int n_ssd = 4 * 66 * 4, n_att = need_ctx ? 1056 : 1024, n_fc = 512 - nfc_early; const int total = n_ssd + n_att + n_fc;
#ifndef REP_DSEL
#define REP_DSEL 0
#endif
          const int xlo = (REP_DSEL == 1) ? 0 : (REP_DSEL == 2) ? n_att : (REP_DSEL == 3) ? n_att + n_ssd : 0;
          const int xn = (REP_D > 1) ? ((REP_DSEL == 1) ? n_att : (REP_DSEL == 2) ? n_ssd : (REP_DSEL == 3) ? n_fc : total) : 0;
          for (int base = 0; base < total + xn; base += c.nblk) { const bool lastr = base + c.nblk > total + xn; const int w0 = base + (lastr ? (c.nblk - 1 - c.bid) : c.bid);
              if (w0 >= total + xn) break;
              const int w = (w0 >= total) ? (xlo + (w0 - total)) : w0;
              __syncthreads();
              if (w < n_att) attn_mfma_unit(c, ws, L, w);
              else if (w < n_att + n_ssd) ssd_state_pair_unit(c, ws, L, w - n_att);
              else fft2_unit(c, ws, w - n_att - n_ssd + nfc_early);
          } }
        SYNC(); REFRESH();
        ph_ssd_scan(c, ws);
        SYNC(); REFRESH();
        for (int w0 = c.bid; w0 < 4 * 66 * 8 * REP_O; w0 += c.nblk) { const int w = (REP_O > 1) ? (w0 % (4 * 66 * 8)) : w0; if (!need_ctx && ((w >> 3) % 66) < 2) continue; __syncthreads(); ssd_out_unit(c, ws, L, w); }
        SYNC(); REFRESH();
        ph_ssm_out2(c, ws, L, nrows);
        SYNC(); REFRESH();
        { pg8::SchedDense S; S.o.init(nMr, 16, c.nblk, c.vbid); S.A = (const GAS char*)(ws + OFF_BR); S.Bt = (const GAS char*)(wb + W_BR); S.a_tile = (size_t)256 * 2048 * 2; S.b_tile = (size_t)256 * 512 * 2; S.a_colgrp = 512 * 2; S.colgrp_shift = 2; S.cs = nullptr; S.rs = nullptr;
          pg8::EpiStore E{(GAS bf16_t*)(ws + OFF_PG), 4096, 0, nullptr, 0, c.lds + 131072};
          for (int rep = 0; rep < REP_G; ++rep) pg8::gemm_phase<pg8::EpiStore, pg8::SchedDense, false>(c.lds, 8, 4096, 1024, S, E); }
        if (defer_w && L == 0 && c.vbid >= 64) ph_weights(c, ws, 0, 704, 896, 0, 0, c.vbid - 64, 192);
        SYNC(); REFRESH();
        { pg8::SchedDense S; S.o.init(nMr, 16, c.nblk, c.vbid); S.A = (const GAS char*)(ws + OFF_H8); S.Bt = (const GAS char*)(wb + W_GATE); S.a_tile = (size_t)256 * 1024; S.b_tile = (size_t)256 * 1024; S.a_colgrp = 0; S.colgrp_shift = 0; S.cs = (const GAS float*)(ws + OFF_CS) + 4096; S.rs = (const GAS float*)(ws + OFF_HS);
          pg8::EpiGate E{(const GAS bf16_t*)(ws + OFF_PG), gp(c.p->in[I_BGATE]) + (size_t)L * 4096, (GAS bf16_t*)(ws + OFF_BR), c.lds + 131072};
          for (int rep = 0; rep < REP_G; ++rep) pg8::gemm_phase<pg8::EpiGate, pg8::SchedDense, false, 2>(c.lds, 8, 1024, 1024, S, E); }
        if (defer_w && L == 0 && c.vbid >= 64) ph_weights(c, ws, 0, 896, 1280, 0, 0, c.vbid - 64, 192);
        SYNC(); REFRESH();
        { pg8::SchedDense S; S.o.init(nMr, 4, c.nblk, c.vbid); S.A = (const GAS char*)(ws + OFF_BR); S.Bt = (const GAS char*)(wb + W_O); S.a_tile = (size_t)256 * 1024 * 2; S.b_tile = (size_t)256 * 1024 * 2; S.a_colgrp = 0; S.colgrp_shift = 0; S.cs = nullptr; S.rs = nullptr;
          pg8::EpiResid E{(GAS bf16_t*)(ws + OFF_XR), gp(c.p->in[I_X]), gp(c.p->in[I_CTX]), (L == 0) ? 1 : 0, MODL};
          pg8::gemm_phase<pg8::EpiResid, pg8::SchedDense, false>(c.lds, 16, 2048, 2048, S, E); }
        if (defer_w && L == 0 && c.vbid >= 16) for (int q = 0; q < 2; ++q) ph_weights(c, ws, q, 1280, 1280, 1536, 1 << 30, c.vbid - 16, 240, q == 1);
        SYNC(); REFRESH();
        ph_norm2_router(c, ws, L, nrows);
        SYNC(); REFRESH();
        ph_dispatch(c, ws, L, nrows);
        SYNC(); REFRESH();
        { pg8::SchedMoe S; S.G = c.nblk; S.c = c.vbid; S.A = (const GAS char*)(ws + OFF_H8); S.Bt = (const GAS char*)(wb + W_13); S.rowtok = (const GAS int*)(ws + OFF_ROWTOK); S.xinfo = (const GAS int*)(ws + OFF_TILEE) + 512;
          S.a_tile = 0; S.e_stride = (size_t)1024 * 1024; S.b_tile = (size_t)256 * 1024; S.cs = (const GAS float*)(ws + OFF_CS) + 8192; S.rs = (const GAS float*)(ws + OFF_HS);
          pg8::EpiSwiglu E{ws + OFF_ACT};
          for (int rep = 0; rep < REP_G; ++rep) pg8::gemm_phase<pg8::EpiSwiglu, pg8::SchedMoe, true, 2>(c.lds, 8, 1024, 1024, S, E); }
        SYNC(); REFRESH();
        { pg8::SchedMoe S; S.G = c.nblk; S.c = c.vbid; S.A = (const GAS char*)(ws + OFF_ACT); S.Bt = (defer_w && L == 1) ? (const GAS char*)(ws + OFF_W2B) : (const GAS char*)(wb + W_2); S.rowtok = nullptr; S.xinfo = (const GAS int*)(ws + OFF_TILEE) + 512;
          S.a_tile = (size_t)256 * 512; S.e_stride = (size_t)1024 * 512; S.b_tile = (size_t)256 * 512; S.cs = nullptr; S.rs = nullptr;
          pg8::EpiStore E{(GAS bf16_t*)(ws + OFF_MYB), 1024, 0, nullptr, 0, c.lds + 131072};
          for (int rep = 0; rep < REP_G; ++rep) pg8::gemm_phase<pg8::EpiStore, pg8::SchedMoe, false, 1>(c.lds, 4, 512, 512, S, E, 0x7A7A7A7A, 0x7C7C7C7C); }
        SYNC(); REFRESH();
        ph_combine(c, ws, L, nrows);
        if (need_ctx) { for (int rep = 0; rep < REP_W; ++rep) { __syncthreads(); ph_weights(c, ws, L + 1, 0, 1 << 30, 0, defer_w ? 1536 : (1 << 30)); } SYNC(); REFRESH(); }
    }
}

extern "C" void kernel_launch(void* const* d_in, const int* in_sizes, int n_in, void* d_out, int out_size, void* d_ws, size_t ws_size, hipStream_t stream) {
    static int grid = 0;
    if (grid == 0) {
        if (n_in != 27 || out_size != NL * DM || ws_size < WS_END) { fprintf(stderr, "kernel_launch: unexpected problem (n_in %d out %d ws %zu)\n", n_in, out_size, ws_size); grid = -1; return; }
        int dev = 0, cus = 0, per_cu = 0;
        hipGetDevice(&dev); hipDeviceGetAttribute(&cus, hipDeviceAttributeMultiprocessorCount, dev);
        hipFuncSetAttribute((const void*)mega_fwd, hipFuncAttributeMaxDynamicSharedMemorySize, LDS_BYTES);
        hipOccupancyMaxActiveBlocksPerMultiprocessor(&per_cu, (const void*)mega_fwd, 512, LDS_BYTES);
        if (per_cu < 1) { fprintf(stderr, "kernel_launch: occupancy query says %d blocks per CU\n", per_cu); per_cu = 1; }
        grid = cus;
        fprintf(stderr, "kernel_launch: cus %d per_cu %d grid %d ws %zu\n", cus, per_cu, grid, ws_size);
    }
    if (grid < 0) return;
    Params p{};
    for (int i = 0; i < 27; ++i) p.in[i] = (const float*)d_in[i];
    p.out = (float*)d_out; p.ws = (unsigned char*)d_ws;
    void* args[] = {&p};
    hipMemsetAsync((unsigned char*)d_ws + OFF_BAR, 0, XCD_BAR_WORDS * sizeof(unsigned), stream);
    hipError_t e = hipLaunchCooperativeKernel((const void*)mega_fwd, dim3(grid), dim3(512), args, LDS_BYTES, stream);
    if (e != hipSuccess) fprintf(stderr, "cooperative launch failed: %s (grid %d)\n", hipGetErrorString(e), grid);
}
```
